# Optimizing an MI355X kernel written in HIP

```python
import math
import jax, jax.numpy as jnp
from jax import lax
import numpy as np


D_MODEL = 2048
BATCH = 2
SEQ = 8192
DEPTH = 1

SSM_WIDTH = D_MODEL // 2
SSM_GROUP = 16
SSM_GROUPS = SSM_WIDTH // SSM_GROUP
SSM_STATE = 64
ATTN_WIDTH = D_MODEL - SSM_WIDTH
HEAD_DIM = 128
N_HEADS = ATTN_WIDTH // HEAD_DIM
DILATED_BRANCHES = ((128, 1), (512, 4), (2048, 16))
FFN_HIDDEN = ((8 * D_MODEL + 3 * 256 - 1) // (3 * 256)) * 256
IN_PROJ_WIDTH = SSM_WIDTH + 3 * ATTN_WIDTH
N_MOD = 6
DT_MIN = 1e-3
DT_MAX = 1e-1
NORM_EPS = 1e-6
MASK_VALUE = -1e30

kernel_name = "hybrid_s5_dilated_alibi_block"


def _rms(x, w):
    xf = x.astype(jnp.float32)
    y = xf * lax.rsqrt(jnp.mean(xf * xf, axis=-1, keepdims=True) + NORM_EPS)
    return y * w.astype(jnp.float32)


def _modulate(y, shift, scale):
    return y * (1.0 + scale.astype(jnp.float32)[:, None, :]) + shift.astype(jnp.float32)[:, None, :]


def _complex_linear_combine(e1, e2):
    a1r, a1i, b1r, b1i = e1
    a2r, a2i, b2r, b2i = e2
    ar = a1r * a2r - a1i * a2i
    ai = a1r * a2i + a1i * a2r
    br = a2r * b1r - a2i * b1i + b2r
    bi = a2r * b1i + a2i * b1r + b2i
    return ar, ai, br, bi


def _s5_mixer(u, a_re, a_im, log_dt, b_re, b_im, c_re, c_im, d, w_glu):
    B, S, _ = u.shape
    f32 = jnp.float32
    uf = u.astype(f32).reshape(B, S, SSM_GROUPS, SSM_GROUP)
    a_re = a_re.astype(f32)
    a_im = a_im.astype(f32)
    dt = jnp.exp(log_dt.astype(f32))[:, None]
    mag = jnp.exp(a_re * dt)
    abar_re = mag * jnp.cos(a_im * dt)
    abar_im = mag * jnp.sin(a_im * dt)
    num_re = abar_re - 1.0
    num_im = abar_im
    den = a_re * a_re + a_im * a_im
    z_re = (num_re * a_re + num_im * a_im) / den
    z_im = (num_im * a_re - num_re * a_im) / den
    b_re = b_re.astype(f32)
    b_im = b_im.astype(f32)
    bbar_re = z_re[..., None] * b_re - z_im[..., None] * b_im
    bbar_im = z_re[..., None] * b_im + z_im[..., None] * b_re
    bu_re = jnp.einsum('bsgc,gnc->sbgn', uf, bbar_re)
    bu_im = jnp.einsum('bsgc,gnc->sbgn', uf, bbar_im)
    a_seq_re = jnp.broadcast_to(abar_re[None, None], (S, 1, SSM_GROUPS, SSM_STATE))
    a_seq_im = jnp.broadcast_to(abar_im[None, None], (S, 1, SSM_GROUPS, SSM_STATE))
    _, _, h_re, h_im = lax.associative_scan(
        _complex_linear_combine, (a_seq_re, a_seq_im, bu_re, bu_im), axis=0)
    y = (jnp.einsum('sbgn,gcn->bsgc', h_re, c_re.astype(f32))
         - jnp.einsum('sbgn,gcn->bsgc', h_im, c_im.astype(f32))
         + d.astype(f32) * uf)
    y = jax.nn.gelu(y.reshape(B, S, SSM_WIDTH))
    return y * jax.nn.sigmoid(y @ w_glu.astype(f32))


def _dilated_branch(q, k, v, slopes, window, dilation):
    B, S, H, E = q.shape
    blk = window // dilation
    span = blk * dilation
    s_pad = ((S + span - 1) // span) * span
    pad = s_pad - S
    L = s_pad // dilation
    nb = L // blk

    def strided_blocks(t):
        t = jnp.pad(t, ((0, 0), (0, pad), (0, 0), (0, 0)))
        t = t.reshape(B, L, dilation, H, E).transpose(0, 2, 3, 1, 4)
        return t.reshape(B, dilation, H, nb, blk, E)

    qb, kb, vb = strided_blocks(q), strided_blocks(k), strided_blocks(v)

    def with_prev(t):
        prev = jnp.concatenate([jnp.zeros_like(t[:, :, :, :1]), t[:, :, :, :-1]], axis=3)
        return jnp.concatenate([prev, t], axis=4)

    kc, vc = with_prev(kb), with_prev(vb)
    scores = jnp.einsum('bdhnqe,bdhnke->bdhnqk', qb, kc)
    qi = jnp.arange(blk)[:, None]
    ki = jnp.arange(2 * blk)[None, :]
    dist = qi + blk - ki
    band = (dist >= 0) & (dist <= blk)
    first = (jnp.arange(nb) == 0)[:, None, None]
    valid = band[None] & ~(first & (ki < blk)[None])
    bias = -slopes[:, None, None, None] * (dilation * dist).astype(jnp.float32)[None, None]
    scores = jnp.where(valid, scores + bias, MASK_VALUE)
    m = jnp.max(scores, axis=-1)
    p = jnp.exp(scores - m[..., None])
    l = jnp.sum(p, axis=-1)
    o = jnp.einsum('bdhnqk,bdhnke->bdhnqe', p, vc)

    m = m.reshape(B, dilation, H, L).transpose(0, 3, 1, 2).reshape(B, s_pad, H)[:, :S]
    l = l.reshape(B, dilation, H, L).transpose(0, 3, 1, 2).reshape(B, s_pad, H)[:, :S]
    o = o.reshape(B, dilation, H, L, E).transpose(0, 3, 1, 2, 4).reshape(B, s_pad, H, E)[:, :S]
    return m, l, o


def _dilated_attention(q, k, v, q_norm_w, k_norm_w):
    B, S, _ = q.shape
    q = _rms(q.reshape(B, S, N_HEADS, HEAD_DIM), q_norm_w) * (HEAD_DIM ** -0.5)
    k = _rms(k.reshape(B, S, N_HEADS, HEAD_DIM), k_norm_w)
    v = v.astype(jnp.float32).reshape(B, S, N_HEADS, HEAD_DIM)
    slopes = jnp.exp2(-8.0 * jnp.arange(1, N_HEADS + 1, dtype=jnp.float32) / N_HEADS)
    outs = [_dilated_branch(q, k, v, slopes, w, dl) for (w, dl) in DILATED_BRANCHES]
    ms = jnp.stack([o[0] for o in outs])
    ls = jnp.stack([o[1] for o in outs])
    os_ = jnp.stack([o[2] for o in outs])
    w = jnp.exp(ms - jnp.max(ms, axis=0, keepdims=True))
    num = jnp.sum(w[..., None] * os_, axis=0)
    den = jnp.sum(w * ls, axis=0)
    return (num / den[..., None]).reshape(B, S, ATTN_WIDTH)


def setup_inputs(seed: int = 0) -> dict:
    key = jax.random.key(seed)
    ks = jax.random.split(key, 24)
    f32 = jnp.float32
    nrm = lambda k, shape, s: jax.random.normal(k, shape, f32) * s
    D, G, N, C = D_MODEL, SSM_GROUPS, SSM_STATE, SSM_GROUP
    x = jax.random.normal(ks[0], (BATCH, SEQ, D), f32)
    c = jax.random.normal(ks[1], (BATCH, D), f32)
    w_ada = nrm(ks[2], (DEPTH, D, N_MOD * D), 0.5 * D ** -0.5)
    b_ada = nrm(ks[3], (DEPTH, N_MOD * D), 0.05)
    norm1_w = 1.0 + nrm(ks[4], (DEPTH, D), 0.02)
    w_in = nrm(ks[5], (DEPTH, D, IN_PROJ_WIDTH), D ** -0.5)
    ssm_a_re = -0.5 + nrm(ks[6], (DEPTH, G, N), 0.01)
    ssm_a_im = jnp.pi * jnp.arange(N, dtype=f32)[None, None, :] + nrm(ks[7], (DEPTH, G, N), 0.01)
    ssm_log_dt = jax.random.uniform(ks[8], (DEPTH, G), f32, math.log(DT_MIN), math.log(DT_MAX))
    ssm_b_re = nrm(ks[9], (DEPTH, G, N, C), (2 * C) ** -0.5)
    ssm_b_im = nrm(ks[10], (DEPTH, G, N, C), (2 * C) ** -0.5)
    ssm_c_re = nrm(ks[11], (DEPTH, G, C, N), (2 * N) ** -0.5)
    ssm_c_im = nrm(ks[12], (DEPTH, G, C, N), (2 * N) ** -0.5)
    ssm_d = nrm(ks[13], (DEPTH, G, C), 1.0)
    ssm_w_glu = nrm(ks[14], (DEPTH, SSM_WIDTH, SSM_WIDTH), SSM_WIDTH ** -0.5)
    q_norm_w = 1.0 + nrm(ks[15], (DEPTH, HEAD_DIM), 0.02)
    k_norm_w = 1.0 + nrm(ks[16], (DEPTH, HEAD_DIM), 0.02)
    w_out = nrm(ks[17], (DEPTH, D, D), D ** -0.5)
    norm2_w = 1.0 + nrm(ks[18], (DEPTH, D), 0.02)
    w_ffn_gate = nrm(ks[19], (DEPTH, D, FFN_HIDDEN), D ** -0.5)
    w_ffn_up = nrm(ks[20], (DEPTH, D, FFN_HIDDEN), D ** -0.5)
    w_ffn_down = nrm(ks[21], (DEPTH, FFN_HIDDEN, D), FFN_HIDDEN ** -0.5)
    return {"x": x, "c": c, "w_ada": w_ada, "b_ada": b_ada, "norm1_w": norm1_w,
            "w_in": w_in, "ssm_a_re": ssm_a_re, "ssm_a_im": ssm_a_im,
            "ssm_log_dt": ssm_log_dt, "ssm_b_re": ssm_b_re, "ssm_b_im": ssm_b_im,
            "ssm_c_re": ssm_c_re, "ssm_c_im": ssm_c_im, "ssm_d": ssm_d,
            "ssm_w_glu": ssm_w_glu, "q_norm_w": q_norm_w, "k_norm_w": k_norm_w,
            "w_out": w_out, "norm2_w": norm2_w, "w_ffn_gate": w_ffn_gate,
            "w_ffn_up": w_ffn_up, "w_ffn_down": w_ffn_down}


def reference(x, c, w_ada, b_ada, norm1_w, w_in, ssm_a_re, ssm_a_im, ssm_log_dt,
              ssm_b_re, ssm_b_im, ssm_c_re, ssm_c_im, ssm_d, ssm_w_glu,
              q_norm_w, k_norm_w, w_out, norm2_w, w_ffn_gate, w_ffn_up, w_ffn_down):
    cond = jax.nn.silu(c)
    splits = [SSM_WIDTH, SSM_WIDTH + ATTN_WIDTH, SSM_WIDTH + 2 * ATTN_WIDTH]
    for i in range(DEPTH):
        mod = cond @ w_ada[i] + b_ada[i]
        shift1, scale1, gate1, shift2, scale2, gate2 = jnp.split(mod, N_MOD, axis=-1)

        h = _modulate(_rms(x, norm1_w[i]), shift1, scale1).astype(x.dtype)
        proj = h @ w_in[i]
        u, q, k, v = jnp.split(proj, splits, axis=-1)
        y_ssm = _s5_mixer(u, ssm_a_re[i], ssm_a_im[i], ssm_log_dt[i], ssm_b_re[i], ssm_b_im[i],
                          ssm_c_re[i], ssm_c_im[i], ssm_d[i], ssm_w_glu[i])
        y_att = _dilated_attention(q, k, v, q_norm_w[i], k_norm_w[i])
        mixed = jnp.concatenate([y_ssm, y_att], axis=-1).astype(x.dtype) @ w_out[i]
        x = x + gate1[:, None, :] * mixed

        h2 = _modulate(_rms(x, norm2_w[i]), shift2, scale2).astype(x.dtype)
        ffn = (jax.nn.silu(h2 @ w_ffn_gate[i]) * (h2 @ w_ffn_up[i])) @ w_ffn_down[i]
        x = x + gate2[:, None, :] * ffn
    return x
```

```cpp
#include <hip/hip_runtime.h>
#include <cstdio>
#include <cstdint>
#include <cmath>
namespace pg8 {
#define PG8_LAS __attribute__((address_space(3)))
typedef unsigned short bf16_t;
typedef short bf16x8 __attribute__((ext_vector_type(8)));
typedef float f32x4 __attribute__((ext_vector_type(4)));
typedef unsigned u32x4 __attribute__((ext_vector_type(4)));
constexpr int BM = 256, BK = 64, HALF = 128, HTB = HALF * BK * 2  , STAGE_BYTES = 8 * HTB, NXCD = 8, WGM = 8;

__host__ __device__ __forceinline__ int lds_byte(int r, int c) { const int st = (r >> 4) * 2 + (c >> 5), rr = r & 15, cc = c & 31, ob = rr * 64 + cc * 2; return st * 1024 + (ob ^ (((ob >> 9) & 1) << 5)); }
__host__ __device__ __forceinline__ void stage_rc(int b, int& R, int& C) { const int st = b / 1024, sb = b % 1024, swz = sb ^ (((sb >> 9) & 1) << 5); R = (st >> 1) * 16 + swz / 64; C = (st & 1) * 32 + (swz % 64) / 2; }
__host__ __device__ __forceinline__ int perm32(int rho) { const int n = rho >> 4, i = rho & 15; return 8 * (i >> 2) + 4 * n + (i & 3); }

struct Unit { int pm, pn; };
struct Gemm { const bf16_t* A; const bf16_t* Bt; int M, N, K; };

struct StaticOrder {
    int nM, nN, nwg, G, c;
    __host__ __device__ void init(int M, int N, int G_, int c_) { nM = M / BM; nN = N / BM; nwg = nM * nN; G = G_; c = c_; }
    __host__ __device__ bool next(int i, Unit& u) const {
        const long L = (long)i * G + c; if (L >= nwg) return false;
        int wgid = (int)L; { const int q = nwg / NXCD, r = nwg % NXCD, xcd = wgid % NXCD, off = wgid / NXCD; wgid = (xcd < r ? xcd * (q + 1) : r * (q + 1) + (xcd - r) * q) + off; }
        const int nig = WGM * nN, gid = wgid / nig, fm = gid * WGM, gsz = (nM - fm) < WGM ? (nM - fm) : WGM;
        u.pm = fm + ((wgid % nig) % gsz); u.pn = (wgid % nig) / gsz; return true;
    }
    __device__ __forceinline__ void a_ready(const Unit&) const {}
    __device__ __forceinline__ void done(const Unit&) const {}
};

__device__ __forceinline__ unsigned cvt_pk_bf16(float lo, float hi) { unsigned r; asm volatile("v_cvt_pk_bf16_f32 %0, %1, %2" : "=v"(r) : "v"(lo), "v"(hi)); return r; }
typedef float f32x2 __attribute__((ext_vector_type(2)));
__device__ __forceinline__ float bf_lo(unsigned w) { return __uint_as_float(w << 16); }
__device__ __forceinline__ float bf_hi(unsigned w) { return __uint_as_float(w & 0xffff0000u); }
__device__ __forceinline__ float sigm(float z) { return __builtin_amdgcn_rcpf(1.0f + __builtin_amdgcn_exp2f(-1.4426950408889634f * z)); }

struct EpiProj {
    static constexpr bool PERM = true, AFTER_DRAIN = false;
    bf16_t* ug; bf16_t* q; size_t qkv_stride; float* ssqk;
    __device__ __forceinline__ void operator()(const f32x4 (&acc)[2][2][4][2], const Unit& u, int wr, int wc, int fr, int fq) const {
        const int row0 = u.pm * BM + wr * 64 + fr; const int pn = u.pn;
#pragma unroll
        for (int ai = 0; ai < 2; ++ai)
#pragma unroll
            for (int m = 0; m < 4; ++m) { const int row = row0 + ai * HALF + m * 16;
#pragma unroll
                for (int bj = 0; bj < 2; ++bj) { const f32x4 v0 = acc[ai][bj][m][0], v1 = acc[ai][bj][m][1];
                    u32x4 w; w.x = cvt_pk_bf16(v0[0], v0[1]); w.y = cvt_pk_bf16(v0[2], v0[3]); w.z = cvt_pk_bf16(v1[0], v1[1]); w.w = cvt_pk_bf16(v1[2], v1[3]);
                    const int colt = bj * HALF + wc * 32 + 8 * fq;
                    if (pn < 4) { const int gcol = pn * 256 + colt, g = gcol >> 4, c0 = gcol & 15, b = row >> 13, tok = row & 8191;
                        *(u32x4*)(ug + ((size_t)((b * 64 + g) * 8192 + tok)) * 16 + c0) = w; }
                    else { const int sect = (pn - 4) >> 2, ccol = ((pn - 4) & 3) * 256 + colt; bf16_t* dst = q + (size_t)sect * qkv_stride;
                        *(u32x4*)(dst + (size_t)row * 1024 + ccol) = w;
                        if (sect < 2) { float ss = (v0[0] * v0[0] + v0[1] * v0[1]) + (v0[2] * v0[2] + v0[3] * v0[3]) + (v1[0] * v1[0] + v1[1] * v1[1]) + (v1[2] * v1[2] + v1[3] * v1[3]);
                            ss += __shfl_xor(ss, 16); ss += __shfl_xor(ss, 32);
                            if (fq == 0) atomicAdd(ssqk + (size_t)(sect * 8 + (ccol >> 7)) * 16384 + row, ss); } } } }
    }
};
struct EpiGlu {
    static constexpr bool PERM = true, AFTER_DRAIN = false;
    const bf16_t* yg; bf16_t* mixed;
    __device__ __forceinline__ void operator()(const f32x4 (&acc)[2][2][4][2], const Unit& u, int wr, int wc, int fr, int fq) const {
        const int row0 = u.pm * BM + wr * 64 + fr;
#pragma unroll
        for (int ai = 0; ai < 2; ++ai)
#pragma unroll
            for (int m = 0; m < 4; ++m) { const int row = row0 + ai * HALF + m * 16;
#pragma unroll
                for (int bj = 0; bj < 2; ++bj) { const f32x4 z0 = acc[ai][bj][m][0], z1 = acc[ai][bj][m][1];
                    const int col0 = u.pn * BM + bj * HALF + wc * 32 + 8 * fq;
                    const u32x4 y = *(const u32x4*)(yg + (size_t)row * 1024 + col0);
                    u32x4 w;
                    w.x = cvt_pk_bf16(bf_lo(y.x) * sigm(z0[0]), bf_hi(y.x) * sigm(z0[1])); w.y = cvt_pk_bf16(bf_lo(y.y) * sigm(z0[2]), bf_hi(y.y) * sigm(z0[3]));
                    w.z = cvt_pk_bf16(bf_lo(y.z) * sigm(z1[0]), bf_hi(y.z) * sigm(z1[1])); w.w = cvt_pk_bf16(bf_lo(y.w) * sigm(z1[2]), bf_hi(y.w) * sigm(z1[3]));
                    *(u32x4*)(mixed + (size_t)row * 2048 + col0) = w; } }
    }
};
struct EpiOut {
    static constexpr bool PERM = false, AFTER_DRAIN = false;
    const float* x; float* x1; bf16_t* a2; const float* mod; const float* n2w; float* ss2;
    __device__ __forceinline__ void operator()(const f32x4 (&acc)[2][2][4][2], const Unit& u, int wr, int wc, int fr, int fq) const {
        typedef unsigned u32x2v __attribute__((ext_vector_type(2)));
        const int row0 = u.pm * BM + wr * 64 + fr, b = (u.pm * BM) >> 13, colb = u.pn * BM + wc * 32 + 4 * fq;
        f32x4 g1[2][2], wv[2][2];
#pragma unroll
        for (int bj = 0; bj < 2; ++bj)
#pragma unroll
            for (int n = 0; n < 2; ++n) { const int col = colb + bj * HALF + n * 16;
                g1[bj][n] = *(const f32x4*)(mod + b * 12288 + 2 * 2048 + col);
                const f32x4 sc = *(const f32x4*)(mod + b * 12288 + 4 * 2048 + col), nw = *(const f32x4*)(n2w + col);
                wv[bj][n] = nw * (sc + 1.0f); }
#pragma unroll
        for (int ai = 0; ai < 2; ++ai)
#pragma unroll
            for (int m = 0; m < 4; ++m) { const int row = row0 + ai * HALF + m * 16; float ss = 0.f;
#pragma unroll
                for (int bj = 0; bj < 2; ++bj)
#pragma unroll
                    for (int n = 0; n < 2; ++n) { const size_t off = (size_t)row * 2048 + colb + bj * HALF + n * 16;
                        const f32x4 o = *(const f32x4*)(x + off) + g1[bj][n] * acc[ai][bj][m][n];
                        *(f32x4*)(x1 + off) = o; ss += (o[0] * o[0] + o[1] * o[1]) + (o[2] * o[2] + o[3] * o[3]);
                        const f32x4 a = o * wv[bj][n]; u32x2v w; w.x = cvt_pk_bf16(a[0], a[1]); w.y = cvt_pk_bf16(a[2], a[3]);
                        *(u32x2v*)(a2 + off) = w; }
                ss += __shfl_xor(ss, 16); ss += __shfl_xor(ss, 32);
                if (fq == 0) atomicAdd(ss2 + row, ss); }
    }
};
struct EpiFfnUp {
    static constexpr bool PERM = true, AFTER_DRAIN = false;
    bf16_t* t; const float* cb; const float* ss2;
    __device__ __forceinline__ void operator()(const f32x4 (&acc)[2][2][4][2], const Unit& u, int wr, int wc, int fr, int fq) const {
        const int row0 = u.pm * BM + wr * 64 + fr, b = (u.pm * BM) >> 13, colt = wc * 32 + 8 * fq;
        const float* cbp = cb + b * 11264 + u.pn * 256 + colt;
        const f32x4 cg0 = *(const f32x4*)(cbp), cg1 = *(const f32x4*)(cbp + 4), cu0 = *(const f32x4*)(cbp + 128), cu1 = *(const f32x4*)(cbp + 132);
#pragma unroll
        for (int ai = 0; ai < 2; ++ai)
#pragma unroll
            for (int m = 0; m < 4; ++m) { const int row = row0 + ai * HALF + m * 16;
                const float rstd = 1.0f / sqrtf(ss2[row] * (1.0f / 2048.0f) + 1e-6f);
                const f32x4 g0 = acc[ai][0][m][0] * rstd + cg0, g1 = acc[ai][0][m][1] * rstd + cg1, u0 = acc[ai][1][m][0] * rstd + cu0, u1 = acc[ai][1][m][1] * rstd + cu1;
                u32x4 w;
                w.x = cvt_pk_bf16(g0[0] * sigm(g0[0]) * u0[0], g0[1] * sigm(g0[1]) * u0[1]); w.y = cvt_pk_bf16(g0[2] * sigm(g0[2]) * u0[2], g0[3] * sigm(g0[3]) * u0[3]);
                w.z = cvt_pk_bf16(g1[0] * sigm(g1[0]) * u1[0], g1[1] * sigm(g1[1]) * u1[1]); w.w = cvt_pk_bf16(g1[2] * sigm(g1[2]) * u1[2], g1[3] * sigm(g1[3]) * u1[3]);
                *(u32x4*)(t + (size_t)row * 5632 + u.pn * 128 + colt) = w; }
    }
};
struct EpiDown {
    static constexpr bool PERM = false, AFTER_DRAIN = false;
    const float* mod; float* out;
    __device__ __forceinline__ void operator()(const f32x4 (&acc)[2][2][4][2], const Unit& u, int wr, int wc, int fr, int fq) const {
        const int row0 = u.pm * BM + wr * 64 + fr, b = (u.pm * BM) >> 13, colb = u.pn * BM + wc * 32 + 4 * fq;
        f32x4 g2[2][2];
#pragma unroll
        for (int bj = 0; bj < 2; ++bj)
#pragma unroll
            for (int n = 0; n < 2; ++n) g2[bj][n] = *(const f32x4*)(mod + b * 12288 + 5 * 2048 + colb + bj * HALF + n * 16);
#pragma unroll
        for (int ai = 0; ai < 2; ++ai)
#pragma unroll
            for (int m = 0; m < 4; ++m) { const int row = row0 + ai * HALF + m * 16;
#pragma unroll
                for (int bj = 0; bj < 2; ++bj)
#pragma unroll
                    for (int n = 0; n < 2; ++n) { float* p = out + (size_t)row * 2048 + colb + bj * HALF + n * 16;
                        *(f32x4*)p = *(const f32x4*)p + g2[bj][n] * acc[ai][bj][m][n]; } }
    }
};
template <class Epi, class Sched, bool ALIGN_EPI = false, bool SP2 = false>
__device__ __forceinline__ void gemm_phase(PG8_LAS unsigned char* lds, const Gemm g, const Sched& S, const Epi& E) {
    const int tid = threadIdx.x, wid = __builtin_amdgcn_readfirstlane(tid >> 6), lane = tid & 63, wr = wid >> 2, wc = wid & 3, fr = lane & 15, fq = lane >> 4;
    const int K = g.K, nt = K / BK;
    unsigned voffA[2], voffB[2];
#pragma unroll
    for (int i = 0; i < 2; ++i) { int R, C; stage_rc(tid * 16 + i * 8192, R, C); const int Rb = Epi::PERM ? ((R & ~31) + perm32(R & 31)) : R;
        voffA[i] = (unsigned)(R * K + C) * 2u; voffB[i] = (unsigned)(Rb * K + C) * 2u; }
    const size_t kstep = (size_t)(BK * 2);
    const size_t hstep = (size_t)HALF * K * 2;
    const size_t tstep = 2 * hstep;
    const unsigned ldsw = (unsigned)wid * 1024u;
    const int aoff = lds_byte(wr * 64 + fr, fq * 8), boff = lds_byte(wc * 32 + fr, fq * 8);
#define PG8_SA(b, h) (((b) * 2 + (h)) * HTB)
#define PG8_SB(b, h) ((4 + (b) * 2 + (h)) * HTB)
#define PG8_STAGE(bufoff, gbase, voff) do { _Pragma("unroll") for (int _i = 0; _i < 2; ++_i) \
        __builtin_amdgcn_global_load_lds((const unsigned*)((const char*)(gbase) + (voff)[_i]), (PG8_LAS unsigned*)(lds + (bufoff) + ldsw + _i * 8192), 16, 0, 0); } while (0)
#define PG8_LDA(dst, b, h) do { _Pragma("unroll") for (int m = 0; m < 4; ++m) _Pragma("unroll") for (int k = 0; k < 2; ++k) dst[m][k] = *(const PG8_LAS bf16x8*)(lds + PG8_SA(b, h) + aoff + m * 2048 + k * 1024); } while (0)
#define PG8_LDB(dst, b, h) do { _Pragma("unroll") for (int n = 0; n < 2; ++n) _Pragma("unroll") for (int k = 0; k < 2; ++k) dst[n][k] = *(const PG8_LAS bf16x8*)(lds + PG8_SB(b, h) + boff + n * 2048 + k * 1024); } while (0)
#define PG8_MMA(ai, bj, At, Bt) do { __builtin_amdgcn_s_setprio(1); _Pragma("unroll") for (int m = 0; m < 4; ++m) _Pragma("unroll") for (int n = 0; n < 2; ++n) _Pragma("unroll") for (int k = 0; k < 2; ++k) \
        acc[ai][bj][m][n] = __builtin_amdgcn_mfma_f32_16x16x32_bf16(Bt[n][k], At[m][k], acc[ai][bj][m][n], 0, 0, 0); __builtin_amdgcn_s_setprio(0); } while (0)
#define PG8_WAIT_V(n) asm volatile("s_waitcnt vmcnt(" #n ")" ::: "memory")
#define PG8_WAIT_L(n) asm volatile("s_waitcnt lgkmcnt(" #n ")" ::: "memory")
#define PG8_BAR __builtin_amdgcn_s_barrier()
#define PG8_SCHED __builtin_amdgcn_sched_barrier(0)
    Unit cur, nxt; int ui = 0;
    if (!S.next(0, cur)) return;
    f32x4 acc[2][2][4][2];
#pragma unroll
    for (int a = 0; a < 2; ++a)
#pragma unroll
        for (int b = 0; b < 2; ++b)
#pragma unroll
            for (int m = 0; m < 4; ++m)
#pragma unroll
                for (int n = 0; n < 2; ++n) acc[a][b][m][n] = (f32x4){0.f, 0.f, 0.f, 0.f};
    bf16x8 At[4][2], B0[2][2], B1[2][2];
    const char* cA = (const char*)g.A + (size_t)cur.pm * tstep; const char* cB = (const char*)g.Bt + (size_t)cur.pn * tstep;
    S.a_ready(cur);
    if constexpr (SP2) {
        PG8_STAGE(PG8_SB(0, 0), cB, voffB); PG8_STAGE(PG8_SB(0, 1), cB + hstep, voffB); PG8_STAGE(PG8_SA(0, 0), cA, voffA); PG8_STAGE(PG8_SA(0, 1), cA + hstep, voffA);
        if (wr == 1) PG8_BAR;
        PG8_WAIT_V(2); PG8_BAR;
        PG8_STAGE(PG8_SB(1, 0), cB + kstep, voffB); PG8_STAGE(PG8_SA(1, 0), cA + kstep, voffA); PG8_STAGE(PG8_SB(1, 1), cB + hstep + kstep, voffB);
        PG8_WAIT_V(6); PG8_BAR;
    } else {
        PG8_STAGE(PG8_SB(0, 0), cB, voffB); PG8_STAGE(PG8_SA(0, 0), cA, voffA); PG8_STAGE(PG8_SB(0, 1), cB + hstep, voffB); PG8_STAGE(PG8_SA(0, 1), cA + hstep, voffA);
        if (wr == 1) PG8_BAR;
        PG8_WAIT_V(4); PG8_BAR;
        PG8_STAGE(PG8_SB(1, 0), cB + kstep, voffB); PG8_STAGE(PG8_SA(1, 0), cA + kstep, voffA); PG8_STAGE(PG8_SB(1, 1), cB + hstep + kstep, voffB);
        PG8_WAIT_V(6); PG8_BAR;
    }
    for (;;) {
        const bool has_next = S.next(ui + 1, nxt);
        const char* nA = has_next ? (const char*)g.A + (size_t)nxt.pm * tstep : cA; const char* nB = has_next ? (const char*)g.Bt + (size_t)nxt.pn * tstep : cB;
        for (int t = 0; t < nt; t += 2) {
            const bool last = (t == nt - 2);
            const char* a1 = cA + (size_t)(t + 1) * kstep;
            const char* a2 = last ? nA : cA + (size_t)(t + 2) * kstep; const char* b2 = last ? nB : cB + (size_t)(t + 2) * kstep;
            const char* a3 = a2 + kstep; const char* b3 = b2 + kstep;
            if (last && has_next) S.a_ready(nxt);
            if constexpr (SP2) {
            PG8_LDB(B0, 0, 0); PG8_LDB(B1, 0, 1); PG8_SCHED; PG8_LDA(At, 0, 0); PG8_STAGE(PG8_SA(1, 1), a1 + hstep, voffA);
            PG8_WAIT_V(8); PG8_WAIT_L(0); PG8_BAR; PG8_MMA(0, 0, At, B0); PG8_MMA(0, 1, At, B1); PG8_BAR; PG8_SCHED;
            PG8_LDA(At, 0, 1); PG8_STAGE(PG8_SB(0, 0), b2, voffB); PG8_STAGE(PG8_SB(0, 1), b2 + hstep, voffB); PG8_STAGE(PG8_SA(0, 0), a2, voffA);
            PG8_WAIT_V(8); PG8_WAIT_L(0); PG8_BAR; PG8_MMA(1, 0, At, B0); PG8_MMA(1, 1, At, B1); PG8_BAR; PG8_SCHED;
            PG8_LDB(B0, 1, 0); PG8_LDB(B1, 1, 1); PG8_SCHED; PG8_LDA(At, 1, 0); PG8_STAGE(PG8_SA(0, 1), a2 + hstep, voffA);
            PG8_WAIT_V(8); PG8_WAIT_L(0); PG8_BAR; PG8_MMA(0, 0, At, B0); PG8_MMA(0, 1, At, B1); PG8_BAR; PG8_SCHED;
            PG8_LDA(At, 1, 1); PG8_STAGE(PG8_SB(1, 0), b3, voffB); PG8_STAGE(PG8_SB(1, 1), b3 + hstep, voffB); PG8_STAGE(PG8_SA(1, 0), a3, voffA);
            PG8_WAIT_V(8); PG8_WAIT_L(0); PG8_BAR; PG8_MMA(1, 0, At, B0); PG8_MMA(1, 1, At, B1); PG8_BAR; PG8_SCHED;
            } else {
            PG8_LDB(B0, 0, 0); PG8_SCHED; PG8_LDA(At, 0, 0); PG8_STAGE(PG8_SA(1, 1), a1 + hstep, voffA);
            PG8_WAIT_L(8); PG8_BAR; PG8_WAIT_L(0); PG8_MMA(0, 0, At, B0); PG8_BAR; PG8_SCHED;
            PG8_LDB(B1, 0, 1); PG8_STAGE(PG8_SB(0, 0), b2, voffB);
            PG8_BAR; PG8_WAIT_L(0); PG8_MMA(0, 1, At, B1); PG8_BAR;
            PG8_LDA(At, 0, 1); PG8_STAGE(PG8_SA(0, 0), a2, voffA);
            PG8_BAR; PG8_WAIT_L(0); PG8_MMA(1, 0, At, B0); PG8_BAR; PG8_SCHED;
            PG8_STAGE(PG8_SB(0, 1), b2 + hstep, voffB);
            PG8_WAIT_V(6); PG8_BAR; PG8_MMA(1, 1, At, B1); PG8_BAR;
            PG8_LDB(B0, 1, 0); PG8_SCHED; PG8_LDA(At, 1, 0); PG8_STAGE(PG8_SA(0, 1), a2 + hstep, voffA);
            PG8_WAIT_L(8); PG8_BAR; PG8_WAIT_L(0); PG8_MMA(0, 0, At, B0); PG8_BAR; PG8_SCHED;
            PG8_LDB(B1, 1, 1); PG8_STAGE(PG8_SB(1, 0), b3, voffB);
            PG8_BAR; PG8_WAIT_L(0); PG8_MMA(0, 1, At, B1); PG8_BAR;
            PG8_LDA(At, 1, 1); PG8_STAGE(PG8_SA(1, 0), a3, voffA);
            PG8_BAR; PG8_WAIT_L(0); PG8_MMA(1, 0, At, B0); PG8_BAR; PG8_SCHED;
            PG8_STAGE(PG8_SB(1, 1), b3 + hstep, voffB);
            PG8_WAIT_V(6); PG8_BAR; PG8_MMA(1, 1, At, B1); PG8_BAR;
            }
        }
        if constexpr (ALIGN_EPI) { if (wr == 0) PG8_BAR; }
        if constexpr (!Epi::AFTER_DRAIN) { E(acc, cur, wr, wc, fr, fq); S.done(cur); }
        if (!has_next) break;
#pragma unroll
        for (int a = 0; a < 2; ++a)
#pragma unroll
            for (int b = 0; b < 2; ++b)
#pragma unroll
                for (int m = 0; m < 4; ++m)
#pragma unroll
                    for (int n = 0; n < 2; ++n) acc[a][b][m][n] = (f32x4){0.f, 0.f, 0.f, 0.f};
        cur = nxt; cA = nA; cB = nB; ++ui;
        if constexpr (ALIGN_EPI) { if (wr == 1) PG8_BAR; }
    }
    PG8_WAIT_V(0);
    if constexpr (!ALIGN_EPI) { if (wr == 0) PG8_BAR; }
    PG8_BAR;
    if constexpr (Epi::AFTER_DRAIN) { E.fused(acc, cur, wr, wc, fr, fq, lds, wid, lane); S.done(cur); }
#undef PG8_SA
#undef PG8_SB
#undef PG8_STAGE
#undef PG8_LDA
#undef PG8_LDB
#undef PG8_MMA
#undef PG8_WAIT_V
#undef PG8_WAIT_L
#undef PG8_BAR
#undef PG8_SCHED
}
}
#define GAS __attribute__((address_space(1)))
#define LAS __attribute__((address_space(3)))
typedef unsigned short bf16;
typedef unsigned v4u __attribute__((ext_vector_type(4)));
typedef float f32x4 __attribute__((ext_vector_type(4)));
typedef short bf16x8 __attribute__((ext_vector_type(8)));
typedef GAS unsigned gu32;
typedef GAS unsigned long long gu64;
#define RLX_AGENT __ATOMIC_RELAXED, __HIP_MEMORY_SCOPE_AGENT
#define LDS_WAIT() asm volatile("s_waitcnt lgkmcnt(0)" ::: "memory")
#define VM_WAIT() asm volatile("s_waitcnt vmcnt(0)" ::: "memory")
__device__ __forceinline__ unsigned long long rt() { return __builtin_amdgcn_s_memrealtime(); }
__device__ __forceinline__ unsigned f2bf(float f) { unsigned u = __builtin_bit_cast(unsigned, f); return (u + 0x7fffu + ((u >> 16) & 1u)) >> 16; }
__device__ __forceinline__ unsigned pk2(float lo, float hi) { return f2bf(lo) | (f2bf(hi) << 16); }

#define XB_TMO      128
#define XB_XCNT(j)  (256  + 64 * (j))
#define XB_XSUB(j)  (1280 + 64 * (j))
#define XB_XGEN(j)  (2304 + 64 * (j))
#define XB_TOP      3328
#define XB_TOPGEN   3392
#define XCD_BAR_WORDS 3456
#define XB_SPIN_CAP (1u << 18)

__device__ __forceinline__ unsigned xb_ld(unsigned* p)              { return __hip_atomic_load(p, __ATOMIC_RELAXED, __HIP_MEMORY_SCOPE_AGENT); }
__device__ __forceinline__ unsigned xb_add(unsigned* p, unsigned v) { return __hip_atomic_fetch_add(p, v, __ATOMIC_RELAXED, __HIP_MEMORY_SCOPE_AGENT); }
__device__ __forceinline__ unsigned xb_xcc_id() { return (unsigned)__builtin_amdgcn_s_getreg((3 << 11) | 20) & 0xFu; }
#define XB_SPIN(cond, bar) do { unsigned _sp = 0; while (cond) { __builtin_amdgcn_s_sleep(1); \
    if ((++_sp & 255u) == 0u) { if (xb_ld(&(bar)[XB_TMO])) break; if (_sp > XB_SPIN_CAP) { atomicAdd(&(bar)[XB_TMO], 1u); break; } } } } while (0)

struct XcdBarrier {
    unsigned* bar; unsigned x;
    volatile LAS unsigned* st;
};

__device__ __forceinline__ XcdBarrier xcd_barrier_post(unsigned* bar, volatile LAS unsigned* st) {
    XcdBarrier b; b.bar = bar; b.x = xb_xcc_id(); b.st = st;
    if (threadIdx.x == 0) (void)xb_add(&bar[XB_XCNT(b.x)], 1u);
    return b;
}
__device__ __forceinline__ void xcd_barrier_complete(unsigned* bar, unsigned x, unsigned& nloc, unsigned& nx) {
    const unsigned G = gridDim.x * gridDim.y * gridDim.z;
    unsigned sum, cnt, mine, sp = 0u;
    for (;;) {
        sum = 0u; cnt = 0u; mine = 0u;
#pragma unroll
        for (unsigned j = 0; j < 16; ++j) { const unsigned c = xb_ld(&bar[XB_XCNT(j)]); sum += c; cnt += (c > 0u) ? 1u : 0u; mine = (j == x) ? c : mine; }
        if (sum == G) break;
        __builtin_amdgcn_s_sleep(1);
        if ((++sp & 255u) == 0u) { if (xb_ld(&bar[XB_TMO])) break; if (sp > XB_SPIN_CAP) { atomicAdd(&bar[XB_TMO], 1u); break; } }
    }
    nloc = mine > 0u ? mine : 1u; nx = cnt > 0u ? cnt : 1u;
}

__device__ __forceinline__ void xcd_barrier(const XcdBarrier& b) {
    asm volatile("s_waitcnt vmcnt(0)" ::: "memory");
    __syncthreads();
    if (threadIdx.x == 0) {
        unsigned* bar = b.bar;
        __builtin_amdgcn_s_waitcnt(0);
        unsigned nloc = b.st[0], nx = b.st[1];
        if (nloc == 0u) { xcd_barrier_complete(bar, b.x, nloc, nx); b.st[0] = nloc; b.st[1] = nx; }
        const unsigned old = xb_add(&bar[XB_XSUB(b.x)], 1u);
        const unsigned gen = old / nloc;
        if (old + 1u == (gen + 1u) * nloc) {
            __builtin_amdgcn_fence(__ATOMIC_RELEASE, "agent");
            asm volatile("s_waitcnt vmcnt(0)" ::: "memory");
            const unsigned og = xb_add(&bar[XB_TOP], 1u);
            const unsigned tg = og / nx;
            if (og + 1u == (tg + 1u) * nx) xb_add(&bar[XB_TOPGEN], 1u);
            else XB_SPIN(xb_ld(&bar[XB_TOPGEN]) == tg, bar);
            __builtin_amdgcn_fence(__ATOMIC_ACQUIRE, "agent");
            xb_add(&bar[XB_XGEN(b.x)], 1u);
            asm volatile("s_waitcnt vmcnt(0)" ::: "memory");
        } else {
            XB_SPIN(xb_ld(&bar[XB_XGEN(b.x)]) == gen, bar);
            __builtin_amdgcn_fence(__ATOMIC_ACQUIRE, "agent");
            asm volatile("s_waitcnt vmcnt(0)" ::: "memory");
        }
    }
    __syncthreads();
}

constexpr int NWAVES = 8;
#ifndef MK_N_LAUNCHES
#define MK_N_LAUNCHES 8
#endif
constexpr int N_PHASES = 8;
constexpr int BATCH = 2, SEQ = 8192, DM = 2048, M = BATCH * SEQ, NPROJ = 4096, FFN = 5632, NGU = 2 * FFN, NMOD = 6 * DM;
constexpr float EPS = 1e-6f;
constexpr size_t MiB = 1u << 20;
constexpr size_t WS_CTL = 0, CTL_ZERO_BYTES = 1 * MiB;
constexpr size_t WS_MOD = 512 * 1024;
constexpr size_t WS_SSQK = 1 * MiB;
constexpr size_t WS_SS2 = 2 * MiB;
constexpr size_t WS_CB = 2 * MiB + 256 * 1024;
constexpr size_t WS_WIN = 4 * MiB, WS_WGLU = 20 * MiB, WS_WOUT = 22 * MiB, WS_WGU = 30 * MiB, WS_WD = 74 * MiB;
constexpr size_t WS_SSMC = 96 * MiB;
constexpr size_t WS_R = 130 * MiB;
constexpr size_t WS_UG = WS_R, WS_Q = WS_R + 32 * MiB, WS_K = WS_R + 64 * MiB, WS_V = WS_R + 96 * MiB, WS_YG = WS_R + 128 * MiB, WS_ATT = WS_R + 160 * MiB;
constexpr size_t WS_H1 = WS_R + 192 * MiB, WS_A2 = WS_R, WS_T = WS_R + 64 * MiB;
constexpr size_t WS_MIXED = 386 * MiB, WS_END = 450 * MiB;
constexpr int CW_TMO = 0, CW_CODE = 1, CW_BAR = 4096;

constexpr int RING_OFF = 0, RING_BYTES = 131072;
constexpr int LDSCTL_OFF = RING_BYTES, MISC_OFF = LDSCTL_OFF + 320;
constexpr int LDS_BYTES = 147456;

struct Frame {
    LAS unsigned char* lds;
    volatile LAS unsigned* MISC;
    gu32* ctl;
    int tid, lane, wave, vcu, G;
    const float* in[22]; float* out; unsigned char* ws;
};
__device__ __forceinline__ float wave_sum(float v) {
#pragma unroll
    for (int o = 1; o < 64; o <<= 1) v += __shfl_xor(v, o);
    return v;
}
__device__ __forceinline__ float wave_max(float v) {
#pragma unroll
    for (int o = 1; o < 64; o <<= 1) v = fmaxf(v, __shfl_xor(v, o));
    return v;
}
__device__ __forceinline__ void p0_transpose_item(const float* W, int K, int N, bf16* WT, int mode, LAS float* scr, int item, int lane) {
    const int nblk = N / 32, kb = item / nblk, nb = item % nblk, k0 = 64 * kb, n0 = 32 * nb;
#pragma unroll 8
    for (int i = 0; i < 32; ++i) { const int kk = 2 * i + (lane >> 5); scr[kk * 33 + (lane & 31)] = W[(size_t)(k0 + kk) * N + n0 + (lane & 31)]; }
    LDS_WAIT(); asm volatile("" ::: "memory");
    const int c = lane & 7;
#pragma unroll
    for (int j = 0; j < 4; ++j) { const int n = (lane >> 3) + 8 * j; const LAS float* s = scr + (8 * c) * 33 + n;
        v4u o; o.x = pk2(s[0 * 33], s[1 * 33]); o.y = pk2(s[2 * 33], s[3 * 33]); o.z = pk2(s[4 * 33], s[5 * 33]); o.w = pk2(s[6 * 33], s[7 * 33]);
        const int ng = n0 + n; const int row = mode == 0 ? ng : ((ng >> 7) * 256 + (ng & 127) + (mode == 2 ? 128 : 0));
        *(GAS v4u*)(WT + (size_t)row * K + k0 + 8 * c) = o; }
    LDS_WAIT(); asm volatile("" ::: "memory");
}
__device__ __forceinline__ void p0_prologue(Frame& F) {
    const float* cin = F.in[1]; const float* w_ada = F.in[2]; const float* b_ada = F.in[3];
    float* mod = (float*)(F.ws + WS_MOD);
    {   LAS float* sbuf = (LAS float*)(F.lds + RING_OFF); LAS float* obuf = (LAS float*)(F.lds + RING_OFF + 1024);
        for (int it = blockIdx.x; it < 192; it += F.G) { const int kc = it / 6, cc = it % 6;
            if (F.tid < 128) { const int b = F.tid >> 6, kk = F.tid & 63; const float cv = cin[b * DM + kc * 64 + kk]; sbuf[b * 64 + kk] = cv / (1.0f + __expf(-cv)); }
            __syncthreads();
            const int col = cc * 2048 + F.tid * 4; f32x4 a0 = {0.f, 0.f, 0.f, 0.f}, a1 = {0.f, 0.f, 0.f, 0.f};
#pragma unroll 8
            for (int kk = 0; kk < 64; ++kk) { const f32x4 w = *(const f32x4*)(w_ada + (size_t)(kc * 64 + kk) * NMOD + col); a0 += w * sbuf[kk]; a1 += w * sbuf[64 + kk]; }
            if (kc == 0) { const f32x4 bb = *(const f32x4*)(b_ada + col); a0 += bb; a1 += bb; }
#pragma unroll
            for (int e = 0; e < 4; ++e) { obuf[F.tid * 4 + e] = a0[e]; obuf[2048 + F.tid * 4 + e] = a1[e]; }
            __syncthreads();
#pragma unroll
            for (int j = 0; j < 4; ++j) { atomicAdd(mod + cc * 2048 + F.tid + 512 * j, obuf[F.tid + 512 * j]); atomicAdd(mod + NMOD + cc * 2048 + F.tid + 512 * j, obuf[2048 + F.tid + 512 * j]); }
            __syncthreads(); } }
    {   f32x4* z = (f32x4*)(F.ws + WS_SSQK); const f32x4 zero = {0.f, 0.f, 0.f, 0.f};
        for (int i = F.vcu * 512 + F.tid; i < 16 * 16384 / 4; i += F.G * 512) z[i] = zero;
        f32x4* z2 = (f32x4*)(F.ws + WS_SS2);
        for (int i = F.vcu * 512 + F.tid; i < 16384 / 4; i += F.G * 512) z2[i] = zero; }
    LAS float* scr = (LAS float*)(F.lds + RING_OFF + F.wave * 16384);
    const int gw = F.vcu * NWAVES + F.wave, NGW = F.G * NWAVES;
    constexpr int I_IN = (DM / 64) * (NPROJ / 32), I_GLU = (1024 / 64) * (1024 / 32), I_OUT = (DM / 64) * (DM / 32), I_G = (DM / 64) * (FFN / 32), I_D = (FFN / 64) * (DM / 32);
    constexpr int NITEMS = I_IN + I_GLU + I_OUT + 2 * I_G + I_D;
    for (int it = gw; it < NITEMS; it += NGW) {
        int r = it;
        if (r < I_IN) { p0_transpose_item(F.in[5], DM, NPROJ, (bf16*)(F.ws + WS_WIN), 0, scr, r, F.lane); continue; } r -= I_IN;
        if (r < I_GLU) { p0_transpose_item(F.in[14], 1024, 1024, (bf16*)(F.ws + WS_WGLU), 0, scr, r, F.lane); continue; } r -= I_GLU;
        if (r < I_OUT) { p0_transpose_item(F.in[17], DM, DM, (bf16*)(F.ws + WS_WOUT), 0, scr, r, F.lane); continue; } r -= I_OUT;
        if (r < I_G) { p0_transpose_item(F.in[19], DM, FFN, (bf16*)(F.ws + WS_WGU), 1, scr, r, F.lane); continue; } r -= I_G;
        if (r < I_G) { p0_transpose_item(F.in[20], DM, FFN, (bf16*)(F.ws + WS_WGU), 2, scr, r, F.lane); continue; } r -= I_G;
        p0_transpose_item(F.in[21], FFN, DM, (bf16*)(F.ws + WS_WD), 0, scr, r, F.lane);
    }
}
__device__ __forceinline__ void p1_norm1(Frame& F) {
    const int gw = F.vcu * NWAVES + F.wave, NGW = F.G * NWAVES;
    const float* x = F.in[0]; const float* n1w = F.in[4]; const float* mod = (const float*)(F.ws + WS_MOD);
    bf16* h1 = (bf16*)(F.ws + WS_H1);
    for (int m = gw; m < M; m += NGW) { const int b = m >> 13;
        const GAS f32x4* xr = (const GAS f32x4*)(x + (size_t)m * DM) + F.lane;
        f32x4 v[8]; float s = 0.f;
#pragma unroll
        for (int j = 0; j < 8; ++j) { v[j] = xr[64 * j]; s += (v[j].x * v[j].x + v[j].y * v[j].y) + (v[j].z * v[j].z + v[j].w * v[j].w); }
        const float rstd = 1.0f / sqrtf(wave_sum(s) * (1.0f / DM) + EPS);
        GAS unsigned long long* o8 = (GAS unsigned long long*)(h1 + (size_t)m * DM) + F.lane;
#pragma unroll
        for (int j = 0; j < 8; ++j) { const int col = 4 * F.lane + 256 * j;
            const f32x4 w = *(const f32x4*)(n1w + col), sc = *(const f32x4*)(mod + b * NMOD + DM + col), sh = *(const f32x4*)(mod + b * NMOD + col);
            const f32x4 h = v[j] * rstd * w * (sc + 1.0f) + sh;
            o8[64 * j] = (unsigned long long)pk2(h.x, h.y) | ((unsigned long long)pk2(h.z, h.w) << 32); } }
    const bf16* wgu = (const bf16*)(F.ws + WS_WGU); float* cb = (float*)(F.ws + WS_CB);
    for (int n = gw; n < NGU; n += NGW) { float d0 = 0.f, d1 = 0.f;
#pragma unroll
        for (int j = 0; j < 4; ++j) { const int k = 8 * F.lane + 512 * j; const v4u w = *(const v4u*)(wgu + (size_t)n * DM + k);
            const float wf[8] = {__uint_as_float(w.x << 16), __uint_as_float(w.x & 0xffff0000u), __uint_as_float(w.y << 16), __uint_as_float(w.y & 0xffff0000u),
                                 __uint_as_float(w.z << 16), __uint_as_float(w.z & 0xffff0000u), __uint_as_float(w.w << 16), __uint_as_float(w.w & 0xffff0000u)};
            const f32x4 s00 = *(const f32x4*)(mod + 3 * DM + k), s01 = *(const f32x4*)(mod + 3 * DM + k + 4), s10 = *(const f32x4*)(mod + NMOD + 3 * DM + k), s11 = *(const f32x4*)(mod + NMOD + 3 * DM + k + 4);
            d0 += wf[0] * s00.x + wf[1] * s00.y + wf[2] * s00.z + wf[3] * s00.w + wf[4] * s01.x + wf[5] * s01.y + wf[6] * s01.z + wf[7] * s01.w;
            d1 += wf[0] * s10.x + wf[1] * s10.y + wf[2] * s10.z + wf[3] * s10.w + wf[4] * s11.x + wf[5] * s11.y + wf[6] * s11.z + wf[7] * s11.w; }
        d0 = wave_sum(d0); d1 = wave_sum(d1);
        if (F.lane == 0) { cb[n] = d0; cb[NGU + n] = d1; } }
}
__device__ __forceinline__ float gelu_tanh(float y) { const float z = 0.7978845608028654f * (y + 0.044715f * y * y * y); const float e = __expf(2.0f * z); return 0.5f * y * (1.0f + (1.0f - 2.0f / (e + 1.0f))); }
__device__ __forceinline__ void p3_ssm_naive(Frame& F) {
    if (F.wave == 0) {
        const bf16* ug = (const bf16*)(F.ws + WS_UG); bf16* yg = (bf16*)(F.ws + WS_YG);
        for (int it = blockIdx.x; it < 128; it += F.G) { const int b = it >> 6, g = it & 63, n = F.lane;
            const float dt = expf(F.in[8][g]), are = F.in[6][g * 64 + n], aim = F.in[7][g * 64 + n];
            const float mag = expf(are * dt), abr = mag * cosf(aim * dt), abi = mag * sinf(aim * dt);
            const float nre = abr - 1.0f, nim = abi, den = are * are + aim * aim;
            const float zre = (nre * are + nim * aim) / den, zim = (nim * are - nre * aim) / den;
            float bbr[16], bbi[16], cre[16], cim[16];
#pragma unroll
            for (int c = 0; c < 16; ++c) { const float br = F.in[9][(g * 64 + n) * 16 + c], bi = F.in[10][(g * 64 + n) * 16 + c];
                bbr[c] = zre * br - zim * bi; bbi[c] = zre * bi + zim * br;
                cre[c] = F.in[11][(g * 16 + c) * 64 + n]; cim[c] = F.in[12][(g * 16 + c) * 64 + n]; }
            const float dl = F.in[13][g * 16 + (F.lane & 15)];
            float hr = 0.f, hi = 0.f;
            const bf16* up = ug + (size_t)((b * 64 + g) * 8192) * 16;
            for (int t = 0; t < SEQ; ++t) {
                const v4u w0 = *(const v4u*)(up + (size_t)t * 16), w1 = *(const v4u*)(up + (size_t)t * 16 + 8);
                const float u[16] = {__uint_as_float(w0.x << 16), __uint_as_float(w0.x & 0xffff0000u), __uint_as_float(w0.y << 16), __uint_as_float(w0.y & 0xffff0000u),
                                     __uint_as_float(w0.z << 16), __uint_as_float(w0.z & 0xffff0000u), __uint_as_float(w0.w << 16), __uint_as_float(w0.w & 0xffff0000u),
                                     __uint_as_float(w1.x << 16), __uint_as_float(w1.x & 0xffff0000u), __uint_as_float(w1.y << 16), __uint_as_float(w1.y & 0xffff0000u),
                                     __uint_as_float(w1.z << 16), __uint_as_float(w1.z & 0xffff0000u), __uint_as_float(w1.w << 16), __uint_as_float(w1.w & 0xffff0000u)};
                float bur = 0.f, bui = 0.f;
#pragma unroll
                for (int c = 0; c < 16; ++c) { bur += bbr[c] * u[c]; bui += bbi[c] * u[c]; }
                const float nr = abr * hr - abi * hi + bur, ni = abr * hi + abi * hr + bui; hr = nr; hi = ni;
                float yv = 0.f, ul = 0.f;
#pragma unroll
                for (int c = 0; c < 16; ++c) { const float p = wave_sum(hr * cre[c] - hi * cim[c]); if ((F.lane & 15) == c) { yv = p; ul = u[c]; } }
                yv += dl * ul;
                if (F.lane < 16) { const float gl = gelu_tanh(yv); yg[(size_t)(b * SEQ + t) * 1024 + g * 16 + F.lane] = (bf16)f2bf(gl); }
            } }
    }
}
__device__ __forceinline__ void p3_attn_naive(Frame& F) {
    const int gw = F.vcu * NWAVES + F.wave, NGW = F.G * NWAVES;
    const bf16* qb = (const bf16*)(F.ws + WS_Q); const bf16* kb = (const bf16*)(F.ws + WS_K); const bf16* vb = (const bf16*)(F.ws + WS_V);
    const float* ssqk = (const float*)(F.ws + WS_SSQK); bf16* mixed = (bf16*)(F.ws + WS_MIXED);
    LAS float* qw = (LAS float*)(F.lds + RING_OFF + F.wave * 1024);
    const float wq0 = F.in[15][2 * F.lane], wq1 = F.in[15][2 * F.lane + 1], wk0 = F.in[16][2 * F.lane], wk1 = F.in[16][2 * F.lane + 1];
    for (int it = gw; it < M * 8; it += NGW) { const int h = it & 7, bt = it >> 3, t = bt & (SEQ - 1), b = bt >> 13;
        const float slope = exp2f(-(float)(h + 1));
        const unsigned qraw = *(const unsigned*)(qb + (size_t)bt * 1024 + h * 128 + 2 * F.lane);
        const float rq = 1.0f / sqrtf(ssqk[(size_t)h * 16384 + bt] * (1.0f / 128.0f) + EPS) * 0.08838834764831845f;
        asm volatile("s_waitcnt lgkmcnt(0)" ::: "memory");
        qw[2 * F.lane] = __uint_as_float(qraw << 16) * rq * wq0 * wk0; qw[2 * F.lane + 1] = __uint_as_float(qraw & 0xffff0000u) * rq * wq1 * wk1;
        asm volatile("s_waitcnt lgkmcnt(0)" ::: "memory");
        float sc[7]; int kt[7]; float mx = -1e30f;
#pragma unroll
        for (int i = 0; i < 7; ++i) { const int p = F.lane + 64 * i; const int br = p / 129, j = p - br * 129; const int dil = br == 0 ? 1 : (br == 1 ? 4 : 16);
            const int kk = t - dil * j; const bool valid = (p < 387) && (kk >= 0); kt[i] = valid ? kk : -1; sc[i] = -1e30f;
            if (valid) { const size_t kr = (size_t)(b * SEQ + kk);
                const v4u* kp = (const v4u*)(kb + kr * 1024 + h * 128); float d = 0.f;
#pragma unroll
                for (int c = 0; c < 16; ++c) { const v4u w = kp[c]; const LAS float* qq = qw + 8 * c;
                    d += __uint_as_float(w.x << 16) * qq[0] + __uint_as_float(w.x & 0xffff0000u) * qq[1] + __uint_as_float(w.y << 16) * qq[2] + __uint_as_float(w.y & 0xffff0000u) * qq[3]
                       + __uint_as_float(w.z << 16) * qq[4] + __uint_as_float(w.z & 0xffff0000u) * qq[5] + __uint_as_float(w.w << 16) * qq[6] + __uint_as_float(w.w & 0xffff0000u) * qq[7]; }
                const float rk = 1.0f / sqrtf(ssqk[(size_t)(8 + h) * 16384 + kr] * (1.0f / 128.0f) + EPS);
                sc[i] = d * rk - slope * (float)(dil * j); mx = fmaxf(mx, sc[i]); } }
        mx = wave_max(mx);
        float ls = 0.f;
#pragma unroll
        for (int i = 0; i < 7; ++i) { sc[i] = kt[i] >= 0 ? __expf(sc[i] - mx) : 0.f; ls += sc[i]; }
        ls = wave_sum(ls);
        float o0 = 0.f, o1 = 0.f;
#pragma unroll
        for (int i = 0; i < 7; ++i)
            for (int src = 0; src < 64; ++src) { const float p = __shfl(sc[i], src); const int kk = __shfl(kt[i], src);
                if (kk >= 0) { const unsigned vv = *(const unsigned*)(vb + (size_t)(b * SEQ + kk) * 1024 + h * 128 + 2 * F.lane); o0 += p * __uint_as_float(vv << 16); o1 += p * __uint_as_float(vv & 0xffff0000u); } }
        const float rl = 1.0f / ls;
        *(unsigned*)(mixed + (size_t)bt * 2048 + 1024 + h * 128 + 2 * F.lane) = pk2(o0 * rl, o1 * rl);
    }
}

struct Args { const float* in[22]; float* out; unsigned char* ws; int ph_lo, ph_hi; };
__global__ void __launch_bounds__(NWAVES * 64, 2) mk_fwd(Args args) {
    extern __shared__ __attribute__((aligned(16))) unsigned char lds[];
    Frame F;
    F.lds = (LAS unsigned char*)lds;
    F.MISC = (volatile LAS unsigned*)(F.lds + MISC_OFF);
    F.tid = threadIdx.x; F.lane = F.tid & 63; F.wave = __builtin_amdgcn_readfirstlane(F.tid >> 6);
    F.G = gridDim.x; { const int bx = blockIdx.x; F.vcu = (F.G % 8 == 0) ? (bx % 8) * (F.G / 8) + bx / 8 : bx; }
    unsigned char* ws = args.ws; F.ws = ws; F.out = args.out;
    F.ctl = (gu32*)(ws + WS_CTL);
#pragma unroll
    for (int i = 0; i < 22; ++i) F.in[i] = args.in[i];
    const int lo = args.ph_lo, hi = args.ph_hi;
    const bool use_bar = (hi - lo) > 1;
    for (int u = F.tid; u < (LDS_BYTES - LDSCTL_OFF) / 4; u += NWAVES * 64) ((LAS unsigned*)(F.lds + LDSCTL_OFF))[u] = 0u;
    __syncthreads();
    XcdBarrier bar; bar.bar = (unsigned*)(F.ctl + CW_BAR); bar.x = 0; bar.st = nullptr;
    if (use_bar) bar = xcd_barrier_post((unsigned*)(F.ctl + CW_BAR), F.MISC + 8);
#define IN(k) (lo <= (k) && (k) < hi)
#define SEAM(k) do { if (IN(k) && IN((k) + 1)) xcd_barrier(bar); } while (0)
    bf16* const W_in_t = (bf16*)(ws + WS_WIN); bf16* const W_glu_t = (bf16*)(ws + WS_WGLU); bf16* const W_out_t = (bf16*)(ws + WS_WOUT);
    bf16* const W_gu_t = (bf16*)(ws + WS_WGU); bf16* const W_d_t = (bf16*)(ws + WS_WD);
    float* const mod = (float*)(ws + WS_MOD); float* const ssqk = (float*)(ws + WS_SSQK); float* const ss2 = (float*)(ws + WS_SS2); float* const cb = (float*)(ws + WS_CB);

    if (IN(0)) { p0_prologue(F); SEAM(0); }
    if (IN(1)) { p1_norm1(F); SEAM(1); }
    if (IN(2)) {
        pg8::Gemm g{(const bf16*)(ws + WS_H1), W_in_t, M, NPROJ, DM}; pg8::StaticOrder S; S.init(M, NPROJ, F.G, (int)blockIdx.x);
        pg8::EpiProj E{(bf16*)(ws + WS_UG), (bf16*)(ws + WS_Q), (size_t)(WS_K - WS_Q) / 2, ssqk};
        pg8::gemm_phase<pg8::EpiProj, pg8::StaticOrder, true, true>(F.lds + RING_OFF, g, S, E);
        SEAM(2);
    }
    if (IN(3)) { p3_ssm_naive(F); p3_attn_naive(F); SEAM(3); }
    if (IN(4)) {
        pg8::Gemm g{(const bf16*)(ws + WS_YG), W_glu_t, M, 1024, 1024}; pg8::StaticOrder S; S.init(M, 1024, F.G, (int)blockIdx.x);
        pg8::EpiGlu E{(const bf16*)(ws + WS_YG), (bf16*)(ws + WS_MIXED)};
        pg8::gemm_phase<pg8::EpiGlu, pg8::StaticOrder, true, true>(F.lds + RING_OFF, g, S, E);
        SEAM(4);
    }
    if (IN(5)) {
        pg8::Gemm g{(const bf16*)(ws + WS_MIXED), W_out_t, M, DM, DM}; pg8::StaticOrder S; S.init(M, DM, F.G, (int)blockIdx.x);
        pg8::EpiOut E{F.in[0], F.out, (bf16*)(ws + WS_A2), mod, F.in[18], ss2};
        pg8::gemm_phase<pg8::EpiOut, pg8::StaticOrder, true, true>(F.lds + RING_OFF, g, S, E);
        SEAM(5);
    }
    if (IN(6)) {
        pg8::Gemm g{(const bf16*)(ws + WS_A2), W_gu_t, M, NGU, DM}; pg8::StaticOrder S; S.init(M, NGU, F.G, (int)blockIdx.x);
        pg8::EpiFfnUp E{(bf16*)(ws + WS_T), cb, ss2};
        pg8::gemm_phase<pg8::EpiFfnUp, pg8::StaticOrder, true, true>(F.lds + RING_OFF, g, S, E);
        SEAM(6);
    }
    if (IN(7)) {
        pg8::Gemm g{(const bf16*)(ws + WS_T), W_d_t, M, DM, FFN}; pg8::StaticOrder S; S.init(M, DM, F.G, (int)blockIdx.x);
        pg8::EpiDown E{mod, F.out};
        pg8::gemm_phase<pg8::EpiDown, pg8::StaticOrder, true, true>(F.lds + RING_OFF, g, S, E);
    }
#undef IN
#undef SEAM
}

extern "C" void kernel_launch(void* const* d_in, const int* in_sizes, int n_in, void* d_out, int out_size, void* d_ws, size_t ws_size, hipStream_t stream) {
    static int grid = 0;
    if (grid == 0) {
        if (n_in != 22 || in_sizes[0] != M * DM || out_size != M * DM || ws_size < WS_END) { fprintf(stderr, "kernel_launch: unexpected shapes (n_in %d, in0 %d, out %d, ws %zu)\n", n_in, n_in > 0 ? in_sizes[0] : -1, out_size, ws_size); grid = -1; return; }
        int dev = 0, cus = 0;
        if (hipGetDevice(&dev) != hipSuccess || hipDeviceGetAttribute(&cus, hipDeviceAttributeMultiprocessorCount, dev) != hipSuccess) { grid = -1; return; }
        if (hipFuncSetAttribute((const void*)mk_fwd, hipFuncAttributeMaxDynamicSharedMemorySize, LDS_BYTES) != hipSuccess) { fprintf(stderr, "kernel_launch: hipFuncSetAttribute failed\n"); grid = -1; return; }
        int per_cu = 0;
        if (hipOccupancyMaxActiveBlocksPerMultiprocessor(&per_cu, (const void*)mk_fwd, NWAVES * 64, LDS_BYTES) != hipSuccess || per_cu < 1) fprintf(stderr, "kernel_launch: occupancy query reports %d\n", per_cu);
        (void)hipGetLastError();
        grid = cus;
    }
    if (grid < 0) return;
    if (hipMemsetAsync((char*)d_ws + WS_CTL, 0, CTL_ZERO_BYTES, stream) != hipSuccess) return;
    Args a{};
    for (int i = 0; i < 22; ++i) a.in[i] = (const float*)d_in[i];
    a.out = (float*)d_out; a.ws = (unsigned char*)d_ws;
    if (MK_N_LAUNCHES == 1) { a.ph_lo = 0; a.ph_hi = N_PHASES; hipLaunchKernelGGL(mk_fwd, dim3(grid), dim3(NWAVES * 64), LDS_BYTES, stream, a); }
    else for (int p = 0; p < N_PHASES; ++p) { a.ph_lo = p; a.ph_hi = p + 1; hipLaunchKernelGGL(mk_fwd, dim3(grid), dim3(NWAVES * 64), LDS_BYTES, stream, a); }
}
```

```cpp
#include <hip/hip_runtime.h>
#include <cstdio>
#include <cstdint>
#include <cmath>
#ifndef NT_STREAM
#define NT_STREAM 1
#endif
#ifndef NT_ACT
#define NT_ACT 1
#endif
#if NT_STREAM
#define NT_LOAD(p) __builtin_nontemporal_load(p)
#else
#define NT_LOAD(p) (*(p))
#endif
#ifndef NT_KV
#define NT_KV 1
#endif
#if NT_KV
#define NT_LOADKV(p) __builtin_nontemporal_load(p)
#else
#define NT_LOADKV(p) (*(p))
#endif
#if NT_ACT
#define NT_LOADA(p) __builtin_nontemporal_load(p)
#else
#define NT_LOADA(p) (*(p))
#endif
namespace pg8 {
#define PG8_LAS __attribute__((address_space(3)))
typedef unsigned short bf16_t;
typedef short bf16x8 __attribute__((ext_vector_type(8)));
typedef float f32x4 __attribute__((ext_vector_type(4)));
typedef unsigned u32x4 __attribute__((ext_vector_type(4)));
constexpr int BM = 256, BK = 64, HALF = 128, HTB = HALF * BK * 2  , STAGE_BYTES = 8 * HTB, NXCD = 8, WGM = 8;

__host__ __device__ __forceinline__ int lds_byte(int r, int c) { const int st = (r >> 4) * 2 + (c >> 5), rr = r & 15, cc = c & 31, ob = rr * 64 + cc * 2; return st * 1024 + (ob ^ (((ob >> 9) & 1) << 5)); }
__host__ __device__ __forceinline__ void stage_rc(int b, int& R, int& C) { const int st = b / 1024, sb = b % 1024, swz = sb ^ (((sb >> 9) & 1) << 5); R = (st >> 1) * 16 + swz / 64; C = (st & 1) * 32 + (swz % 64) / 2; }
__host__ __device__ __forceinline__ int perm32(int rho) { const int n = rho >> 4, i = rho & 15; return 8 * (i >> 2) + 4 * n + (i & 3); }

struct Unit { int pm, pn; };
struct Gemm { const bf16_t* A; const bf16_t* Bt; int M, N, K; size_t bstride; };

struct StaticOrder {
    int nM, nN, nwg, G, c, wgm;
    __host__ __device__ void init(int M, int N, int G_, int c_, int wgm_ = WGM) { nM = M / BM; nN = N / BM; nwg = nM * nN; G = G_; c = c_; wgm = wgm_; }
    __host__ __device__ bool next(int i, Unit& u) const {
        const long L = (long)i * G + c; if (L >= nwg) return false;
        int wgid = (int)L; { const int q = nwg / NXCD, r = nwg % NXCD, xcd = wgid % NXCD, off = wgid / NXCD; wgid = (xcd < r ? xcd * (q + 1) : r * (q + 1) + (xcd - r) * q) + off; }
        const int nig = wgm * nN, gid = wgid / nig, fm = gid * wgm, gsz = (nM - fm) < wgm ? (nM - fm) : wgm;
        u.pm = fm + ((wgid % nig) % gsz); u.pn = (wgid % nig) / gsz; return true;
    }
    __device__ __forceinline__ void a_ready(const Unit&) const {}
    __device__ __forceinline__ void done(const Unit&) const {}
};

__device__ __forceinline__ unsigned cvt_pk_bf16(float lo, float hi) { unsigned r; asm volatile("v_cvt_pk_bf16_f32 %0, %1, %2" : "=v"(r) : "v"(lo), "v"(hi)); return r; }
typedef float f32x2 __attribute__((ext_vector_type(2)));
__device__ __forceinline__ float bf_lo(unsigned w) { return __uint_as_float(w << 16); }
__device__ __forceinline__ float bf_hi(unsigned w) { return __uint_as_float(w & 0xffff0000u); }
__device__ __forceinline__ float sigm(float z) { return __builtin_amdgcn_rcpf(1.0f + __builtin_amdgcn_exp2f(-1.4426950408889634f * z)); }

struct EpiProj {
    static constexpr bool PERM = true, AFTER_DRAIN = false;
    bf16_t* ug; bf16_t* q; size_t qkv_stride; float* ssqk;
    __device__ __forceinline__ void operator()(const f32x4 (&acc)[2][2][4][2], const Unit& u, int wr, int wc, int fr, int fq) const {
        const int row0 = u.pm * BM + wr * 64 + fr; const int pn = u.pn;
#pragma unroll
        for (int ai = 0; ai < 2; ++ai)
#pragma unroll
            for (int m = 0; m < 4; ++m) { const int row = row0 + ai * HALF + m * 16;
#pragma unroll
                for (int bj = 0; bj < 2; ++bj) { const f32x4 v0 = acc[ai][bj][m][0], v1 = acc[ai][bj][m][1];
                    u32x4 w; w.x = cvt_pk_bf16(v0[0], v0[1]); w.y = cvt_pk_bf16(v0[2], v0[3]); w.z = cvt_pk_bf16(v1[0], v1[1]); w.w = cvt_pk_bf16(v1[2], v1[3]);
                    const int colt = bj * HALF + wc * 32 + 8 * fq;
                    if (pn < 4) { const int gcol = pn * 256 + colt, g = gcol >> 4, c0 = gcol & 15, b = row >> 13, tok = row & 8191;
                        *(u32x4*)(ug + ((size_t)((b * 64 + g) * 8192 + tok)) * 16 + c0) = w; }
                    else { const int sect = (pn - 4) >> 2, ccol = ((pn - 4) & 3) * 256 + colt; bf16_t* dst = q + (size_t)sect * qkv_stride;
                        *(u32x4*)(dst + (size_t)row * 1024 + ccol) = w;
                        if (sect < 2) { float ss = (v0[0] * v0[0] + v0[1] * v0[1]) + (v0[2] * v0[2] + v0[3] * v0[3]) + (v1[0] * v1[0] + v1[1] * v1[1]) + (v1[2] * v1[2] + v1[3] * v1[3]);
                            ss += __shfl_xor(ss, 16); ss += __shfl_xor(ss, 32);
                            if (fq == 0) atomicAdd(ssqk + (size_t)(sect * 8 + (ccol >> 7)) * 16384 + row, ss); } } } }
    }
};
struct EpiGlu {
    static constexpr bool PERM = true, AFTER_DRAIN = false;
    const bf16_t* yg; bf16_t* mixed;
    __device__ __forceinline__ void operator()(const f32x4 (&acc)[2][2][4][2], const Unit& u, int wr, int wc, int fr, int fq) const {
        const int row0 = u.pm * BM + wr * 64 + fr, colw = u.pn * BM + wc * 32 + 8 * fq;
        u32x4 yv[2][4][2];
#pragma unroll
        for (int ai = 0; ai < 2; ++ai)
#pragma unroll
            for (int m = 0; m < 4; ++m)
#pragma unroll
                for (int bj = 0; bj < 2; ++bj) yv[ai][m][bj] = *(const u32x4*)(yg + (size_t)(row0 + ai * HALF + m * 16) * 1024 + colw + bj * HALF);
#pragma unroll
        for (int ai = 0; ai < 2; ++ai)
#pragma unroll
            for (int m = 0; m < 4; ++m) { const int row = row0 + ai * HALF + m * 16;
#pragma unroll
                for (int bj = 0; bj < 2; ++bj) { const f32x4 z0 = acc[ai][bj][m][0], z1 = acc[ai][bj][m][1]; const u32x4 y = yv[ai][m][bj];
                    u32x4 w;
                    w.x = cvt_pk_bf16(bf_lo(y.x) * sigm(z0[0]), bf_hi(y.x) * sigm(z0[1])); w.y = cvt_pk_bf16(bf_lo(y.y) * sigm(z0[2]), bf_hi(y.y) * sigm(z0[3]));
                    w.z = cvt_pk_bf16(bf_lo(y.z) * sigm(z1[0]), bf_hi(y.z) * sigm(z1[1])); w.w = cvt_pk_bf16(bf_lo(y.w) * sigm(z1[2]), bf_hi(y.w) * sigm(z1[3]));
                    *(u32x4*)(mixed + (size_t)row * 2048 + colw + bj * HALF) = w; } }
    }
};
struct EpiOut {
    static constexpr bool PERM = true, AFTER_DRAIN = false;
    const float* x; bf16_t* x1b; const float* mod; float* ss2;
    __device__ __forceinline__ void operator()(const f32x4 (&acc)[2][2][4][2], const Unit& u, int wr, int wc, int fr, int fq) const {
        const int row0 = u.pm * BM + wr * 64 + fr, b = (u.pm * BM) >> 13, colb = u.pn * BM + wc * 32 + 8 * fq;
        f32x4 g1[2][2];
#pragma unroll
        for (int bj = 0; bj < 2; ++bj)
#pragma unroll
            for (int n = 0; n < 2; ++n) g1[bj][n] = *(const f32x4*)(mod + b * 12288 + 2 * 2048 + colb + bj * HALF + n * 4);
        f32x4 xr[4][2][2]; u32x4 w0[4][2]; float ss0[4];
#define EPIOUT_LOAD(ai_) do { _Pragma("unroll") for (int m = 0; m < 4; ++m) _Pragma("unroll") for (int bj = 0; bj < 2; ++bj) _Pragma("unroll") for (int n = 0; n < 2; ++n) \
            xr[m][bj][n] = NT_LOADA((const f32x4*)(x + (size_t)(row0 + (ai_) * HALF + m * 16) * 2048 + colb + bj * HALF + n * 4)); } while (0)
#define EPIOUT_COMP(ai_, W_, SS_) do { _Pragma("unroll") for (int m = 0; m < 4; ++m) { float ss = 0.f; _Pragma("unroll") for (int bj = 0; bj < 2; ++bj) { \
            const f32x4 o0 = xr[m][bj][0] + g1[bj][0] * acc[ai_][bj][m][0], o1 = xr[m][bj][1] + g1[bj][1] * acc[ai_][bj][m][1]; \
            ss += ((o0[0] * o0[0] + o0[1] * o0[1]) + (o0[2] * o0[2] + o0[3] * o0[3])) + ((o1[0] * o1[0] + o1[1] * o1[1]) + (o1[2] * o1[2] + o1[3] * o1[3])); \
            u32x4 w; w.x = cvt_pk_bf16(o0[0], o0[1]); w.y = cvt_pk_bf16(o0[2], o0[3]); w.z = cvt_pk_bf16(o1[0], o1[1]); w.w = cvt_pk_bf16(o1[2], o1[3]); W_[m][bj] = w; } \
            ss += __shfl_xor(ss, 16); ss += __shfl_xor(ss, 32); SS_[m] = ss; } } while (0)
#define EPIOUT_STORE(ai_, W_, SS_) do { _Pragma("unroll") for (int m = 0; m < 4; ++m) { const int row = row0 + (ai_) * HALF + m * 16; \
            _Pragma("unroll") for (int bj = 0; bj < 2; ++bj) *(u32x4*)(x1b + (size_t)row * 2048 + colb + bj * HALF) = W_[m][bj]; \
            if (fq == 0) atomicAdd(ss2 + row, SS_[m]); } } while (0)
        EPIOUT_LOAD(0); EPIOUT_COMP(0, w0, ss0);
        asm volatile("" ::: "memory");
        EPIOUT_LOAD(1);
        asm volatile("" ::: "memory");
        EPIOUT_STORE(0, w0, ss0);
        u32x4 w1[4][2]; float ss1[4];
        EPIOUT_COMP(1, w1, ss1); EPIOUT_STORE(1, w1, ss1);
#undef EPIOUT_LOAD
#undef EPIOUT_COMP
#undef EPIOUT_STORE
    }
};
struct EpiFfnUp {
    static constexpr bool PERM = true, AFTER_DRAIN = false;
    bf16_t* t; const float* cb; const float* ss2;
    __device__ __forceinline__ void operator()(const f32x4 (&acc)[2][2][4][2], const Unit& u, int wr, int wc, int fr, int fq) const {
        const int row0 = u.pm * BM + wr * 64 + fr, b = (u.pm * BM) >> 13, colt = wc * 32 + 8 * fq;
        const float* cbp = cb + b * 11264 + u.pn * 256 + colt;
        const f32x4 cg0 = *(const f32x4*)(cbp), cg1 = *(const f32x4*)(cbp + 4), cu0 = *(const f32x4*)(cbp + 128), cu1 = *(const f32x4*)(cbp + 132);
        float rs[2][4];
#pragma unroll
        for (int ai = 0; ai < 2; ++ai)
#pragma unroll
            for (int m = 0; m < 4; ++m) rs[ai][m] = ss2[row0 + ai * HALF + m * 16];
#pragma unroll
        for (int ai = 0; ai < 2; ++ai)
#pragma unroll
            for (int m = 0; m < 4; ++m) rs[ai][m] = __builtin_amdgcn_rsqf(rs[ai][m] * (1.0f / 2048.0f) + 1e-6f);
#pragma unroll
        for (int ai = 0; ai < 2; ++ai)
#pragma unroll
            for (int m = 0; m < 4; ++m) { const int row = row0 + ai * HALF + m * 16; const float rstd = rs[ai][m];
                const f32x4 g0 = acc[ai][0][m][0] * rstd + cg0, g1 = acc[ai][0][m][1] * rstd + cg1, u0 = acc[ai][1][m][0] * rstd + cu0, u1 = acc[ai][1][m][1] * rstd + cu1;
                u32x4 w;
                w.x = cvt_pk_bf16(g0[0] * sigm(g0[0]) * u0[0], g0[1] * sigm(g0[1]) * u0[1]); w.y = cvt_pk_bf16(g0[2] * sigm(g0[2]) * u0[2], g0[3] * sigm(g0[3]) * u0[3]);
                w.z = cvt_pk_bf16(g1[0] * sigm(g1[0]) * u1[0], g1[1] * sigm(g1[1]) * u1[1]); w.w = cvt_pk_bf16(g1[2] * sigm(g1[2]) * u1[2], g1[3] * sigm(g1[3]) * u1[3]);
                *(u32x4*)(t + (size_t)row * 5632 + u.pn * 128 + colt) = w; }
    }
};
struct EpiDown {
    static constexpr bool PERM = true, AFTER_DRAIN = false;
    const float* mod; const bf16_t* x1b; float* out;
    __device__ __forceinline__ void operator()(const f32x4 (&acc)[2][2][4][2], const Unit& u, int wr, int wc, int fr, int fq) const {
        const int row0 = u.pm * BM + wr * 64 + fr, b = (u.pm * BM) >> 13, colb = u.pn * BM + wc * 32 + 8 * fq;
        f32x4 g2[2][2];
#pragma unroll
        for (int bj = 0; bj < 2; ++bj)
#pragma unroll
            for (int n = 0; n < 2; ++n) g2[bj][n] = *(const f32x4*)(mod + b * 12288 + 5 * 2048 + colb + bj * HALF + n * 4);
        u32x4 xr[2][4][2];
#pragma unroll
        for (int ai = 0; ai < 2; ++ai)
#pragma unroll
            for (int m = 0; m < 4; ++m)
#pragma unroll
                for (int bj = 0; bj < 2; ++bj) xr[ai][m][bj] = *(const u32x4*)(x1b + (size_t)(row0 + ai * HALF + m * 16) * 2048 + colb + bj * HALF);
#pragma unroll
        for (int ai = 0; ai < 2; ++ai)
#pragma unroll
            for (int m = 0; m < 4; ++m) { const int row = row0 + ai * HALF + m * 16;
#pragma unroll
                for (int bj = 0; bj < 2; ++bj) { const u32x4 r = xr[ai][m][bj];
                    const f32x4 x0 = {bf_lo(r.x), bf_hi(r.x), bf_lo(r.y), bf_hi(r.y)}, x1 = {bf_lo(r.z), bf_hi(r.z), bf_lo(r.w), bf_hi(r.w)};
                    float* op = out + (size_t)row * 2048 + colb + bj * HALF;
                    *(f32x4*)op = x0 + g2[bj][0] * acc[ai][bj][m][0]; *(f32x4*)(op + 4) = x1 + g2[bj][1] * acc[ai][bj][m][1]; } }
    }
};
template <class Epi, class Sched, bool ALIGN_EPI = false, bool SP2 = false>
__device__ __forceinline__ void gemm_phase(PG8_LAS unsigned char* lds, const Gemm g, const Sched& S, const Epi& E) {
    const int tid = threadIdx.x, wid = __builtin_amdgcn_readfirstlane(tid >> 6), lane = tid & 63, wr = wid >> 2, wc = wid & 3, fr = lane & 15, fq = lane >> 4;
    const int K = g.K, nt = K / BK;
    unsigned voffA[2], voffB[2];
#pragma unroll
    for (int i = 0; i < 2; ++i) { int R, C; stage_rc(tid * 16 + i * 8192, R, C); const int Rb = Epi::PERM ? ((R & ~31) + perm32(R & 31)) : R;
        voffA[i] = (unsigned)(R * K + C) * 2u; voffB[i] = (unsigned)(Rb * K + C) * 2u; }
    const size_t kstep = (size_t)(BK * 2);
    const size_t hstep = (size_t)HALF * K * 2;
    const size_t tstep = 2 * hstep;
    const unsigned ldsw = (unsigned)wid * 1024u;
    const int aoff = lds_byte(wr * 64 + fr, fq * 8), boff = lds_byte(wc * 32 + fr, fq * 8);
#define PG8_SA(b, h) (((b) * 2 + (h)) * HTB)
#define PG8_SB(b, h) ((4 + (b) * 2 + (h)) * HTB)
#define PG8_STAGE(bufoff, gbase, voff) do { _Pragma("unroll") for (int _i = 0; _i < 2; ++_i) \
        __builtin_amdgcn_global_load_lds((const unsigned*)((const char*)(gbase) + (voff)[_i]), (PG8_LAS unsigned*)(lds + (bufoff) + ldsw + _i * 8192), 16, 0, 0); } while (0)
#define PG8_LDA(dst, b, h) do { _Pragma("unroll") for (int m = 0; m < 4; ++m) _Pragma("unroll") for (int k = 0; k < 2; ++k) dst[m][k] = *(const PG8_LAS bf16x8*)(lds + PG8_SA(b, h) + aoff + m * 2048 + k * 1024); } while (0)
#define PG8_LDB(dst, b, h) do { _Pragma("unroll") for (int n = 0; n < 2; ++n) _Pragma("unroll") for (int k = 0; k < 2; ++k) dst[n][k] = *(const PG8_LAS bf16x8*)(lds + PG8_SB(b, h) + boff + n * 2048 + k * 1024); } while (0)
#define PG8_MMA(ai, bj, At, Bt) do { __builtin_amdgcn_s_setprio(1); _Pragma("unroll") for (int m = 0; m < 4; ++m) _Pragma("unroll") for (int n = 0; n < 2; ++n) _Pragma("unroll") for (int k = 0; k < 2; ++k) \
        acc[ai][bj][m][n] = __builtin_amdgcn_mfma_f32_16x16x32_bf16(Bt[n][k], At[m][k], acc[ai][bj][m][n], 0, 0, 0); __builtin_amdgcn_s_setprio(0); } while (0)
#define PG8_WAIT_V(n) asm volatile("s_waitcnt vmcnt(" #n ")" ::: "memory")
#define PG8_WAIT_L(n) asm volatile("s_waitcnt lgkmcnt(" #n ")" ::: "memory")
#define PG8_BAR __builtin_amdgcn_s_barrier()
#define PG8_SCHED __builtin_amdgcn_sched_barrier(0)
    Unit cur, nxt; int ui = 0;
    if (!S.next(0, cur)) return;
    f32x4 acc[2][2][4][2];
#pragma unroll
    for (int a = 0; a < 2; ++a)
#pragma unroll
        for (int b = 0; b < 2; ++b)
#pragma unroll
            for (int m = 0; m < 4; ++m)
#pragma unroll
                for (int n = 0; n < 2; ++n) acc[a][b][m][n] = (f32x4){0.f, 0.f, 0.f, 0.f};
    bf16x8 At[4][2], B0[2][2], B1[2][2];
    const char* cA = (const char*)g.A + (size_t)cur.pm * tstep; const char* cB = (const char*)g.Bt + (size_t)cur.pn * tstep + ((cur.pm >> 5) ? g.bstride : (size_t)0);
    S.a_ready(cur);
    if constexpr (SP2) {
        PG8_STAGE(PG8_SB(0, 0), cB, voffB); PG8_STAGE(PG8_SB(0, 1), cB + hstep, voffB); PG8_STAGE(PG8_SA(0, 0), cA, voffA); PG8_STAGE(PG8_SA(0, 1), cA + hstep, voffA);
        if (wr == 1) PG8_BAR;
        PG8_WAIT_V(2); PG8_BAR;
        PG8_STAGE(PG8_SB(1, 0), cB + kstep, voffB); PG8_STAGE(PG8_SA(1, 0), cA + kstep, voffA); PG8_STAGE(PG8_SB(1, 1), cB + hstep + kstep, voffB);
        PG8_WAIT_V(6); PG8_BAR;
    } else {
        PG8_STAGE(PG8_SB(0, 0), cB, voffB); PG8_STAGE(PG8_SA(0, 0), cA, voffA); PG8_STAGE(PG8_SB(0, 1), cB + hstep, voffB); PG8_STAGE(PG8_SA(0, 1), cA + hstep, voffA);
        if (wr == 1) PG8_BAR;
        PG8_WAIT_V(4); PG8_BAR;
        PG8_STAGE(PG8_SB(1, 0), cB + kstep, voffB); PG8_STAGE(PG8_SA(1, 0), cA + kstep, voffA); PG8_STAGE(PG8_SB(1, 1), cB + hstep + kstep, voffB);
        PG8_WAIT_V(6); PG8_BAR;
    }
    for (;;) {
        const bool has_next = S.next(ui + 1, nxt);
        const char* nA = has_next ? (const char*)g.A + (size_t)nxt.pm * tstep : cA; const char* nB = has_next ? (const char*)g.Bt + (size_t)nxt.pn * tstep + ((nxt.pm >> 5) ? g.bstride : (size_t)0) : cB;
        for (int t = 0; t < nt; t += 2) {
            const bool last = (t == nt - 2);
            const char* a1 = cA + (size_t)(t + 1) * kstep;
            const char* a2 = last ? nA : cA + (size_t)(t + 2) * kstep; const char* b2 = last ? nB : cB + (size_t)(t + 2) * kstep;
            const char* a3 = a2 + kstep; const char* b3 = b2 + kstep;
            if (last && has_next) S.a_ready(nxt);
            if constexpr (SP2) {
            PG8_LDB(B0, 0, 0); PG8_LDB(B1, 0, 1); PG8_SCHED; PG8_LDA(At, 0, 0); PG8_STAGE(PG8_SA(1, 1), a1 + hstep, voffA);
            PG8_WAIT_V(8); PG8_WAIT_L(0); PG8_BAR; PG8_MMA(0, 0, At, B0); PG8_MMA(0, 1, At, B1); PG8_BAR; PG8_SCHED;
            PG8_LDA(At, 0, 1); PG8_STAGE(PG8_SB(0, 0), b2, voffB); PG8_STAGE(PG8_SB(0, 1), b2 + hstep, voffB); PG8_STAGE(PG8_SA(0, 0), a2, voffA);
            PG8_WAIT_V(8); PG8_WAIT_L(0); PG8_BAR; PG8_MMA(1, 0, At, B0); PG8_MMA(1, 1, At, B1); PG8_BAR; PG8_SCHED;
            PG8_LDB(B0, 1, 0); PG8_LDB(B1, 1, 1); PG8_SCHED; PG8_LDA(At, 1, 0); PG8_STAGE(PG8_SA(0, 1), a2 + hstep, voffA);
            PG8_WAIT_V(8); PG8_WAIT_L(0); PG8_BAR; PG8_MMA(0, 0, At, B0); PG8_MMA(0, 1, At, B1); PG8_BAR; PG8_SCHED;
            PG8_LDA(At, 1, 1); PG8_STAGE(PG8_SB(1, 0), b3, voffB); PG8_STAGE(PG8_SB(1, 1), b3 + hstep, voffB); PG8_STAGE(PG8_SA(1, 0), a3, voffA);
            PG8_WAIT_V(8); PG8_WAIT_L(0); PG8_BAR; PG8_MMA(1, 0, At, B0); PG8_MMA(1, 1, At, B1); PG8_BAR; PG8_SCHED;
            } else {
            PG8_LDB(B0, 0, 0); PG8_SCHED; PG8_LDA(At, 0, 0); PG8_STAGE(PG8_SA(1, 1), a1 + hstep, voffA);
            PG8_WAIT_L(8); PG8_BAR; PG8_WAIT_L(0); PG8_MMA(0, 0, At, B0); PG8_BAR; PG8_SCHED;
            PG8_LDB(B1, 0, 1); PG8_STAGE(PG8_SB(0, 0), b2, voffB);
            PG8_BAR; PG8_WAIT_L(0); PG8_MMA(0, 1, At, B1); PG8_BAR;
            PG8_LDA(At, 0, 1); PG8_STAGE(PG8_SA(0, 0), a2, voffA);
            PG8_BAR; PG8_WAIT_L(0); PG8_MMA(1, 0, At, B0); PG8_BAR; PG8_SCHED;
            PG8_STAGE(PG8_SB(0, 1), b2 + hstep, voffB);
            PG8_WAIT_V(6); PG8_BAR; PG8_MMA(1, 1, At, B1); PG8_BAR;
            PG8_LDB(B0, 1, 0); PG8_SCHED; PG8_LDA(At, 1, 0); PG8_STAGE(PG8_SA(0, 1), a2 + hstep, voffA);
            PG8_WAIT_L(8); PG8_BAR; PG8_WAIT_L(0); PG8_MMA(0, 0, At, B0); PG8_BAR; PG8_SCHED;
            PG8_LDB(B1, 1, 1); PG8_STAGE(PG8_SB(1, 0), b3, voffB);
            PG8_BAR; PG8_WAIT_L(0); PG8_MMA(0, 1, At, B1); PG8_BAR;
            PG8_LDA(At, 1, 1); PG8_STAGE(PG8_SA(1, 0), a3, voffA);
            PG8_BAR; PG8_WAIT_L(0); PG8_MMA(1, 0, At, B0); PG8_BAR; PG8_SCHED;
            PG8_STAGE(PG8_SB(1, 1), b3 + hstep, voffB);
            PG8_WAIT_V(6); PG8_BAR; PG8_MMA(1, 1, At, B1); PG8_BAR;
            }
        }
        if constexpr (ALIGN_EPI) { if (wr == 0) PG8_BAR; }
        if constexpr (!Epi::AFTER_DRAIN) { E(acc, cur, wr, wc, fr, fq); S.done(cur); }
        if (!has_next) break;
#pragma unroll
        for (int a = 0; a < 2; ++a)
#pragma unroll
            for (int b = 0; b < 2; ++b)
#pragma unroll
                for (int m = 0; m < 4; ++m)
#pragma unroll
                    for (int n = 0; n < 2; ++n) acc[a][b][m][n] = (f32x4){0.f, 0.f, 0.f, 0.f};
        cur = nxt; cA = nA; cB = nB; ++ui;
        if constexpr (ALIGN_EPI) { if (wr == 1) PG8_BAR; }
    }
    PG8_WAIT_V(0);
    if constexpr (!ALIGN_EPI) { if (wr == 0) PG8_BAR; }
    PG8_BAR;
    if constexpr (Epi::AFTER_DRAIN) { E.fused(acc, cur, wr, wc, fr, fq, lds, wid, lane); S.done(cur); }
#undef PG8_SA
#undef PG8_SB
#undef PG8_STAGE
#undef PG8_LDA
#undef PG8_LDB
#undef PG8_MMA
#undef PG8_WAIT_V
#undef PG8_WAIT_L
#undef PG8_BAR
#undef PG8_SCHED
}
}
#define GAS __attribute__((address_space(1)))
#define LAS __attribute__((address_space(3)))
typedef unsigned short bf16;
typedef unsigned v4u __attribute__((ext_vector_type(4)));
typedef float f32x4 __attribute__((ext_vector_type(4)));
typedef short bf16x8 __attribute__((ext_vector_type(8)));
typedef GAS unsigned gu32;
typedef GAS unsigned long long gu64;
#define RLX_AGENT __ATOMIC_RELAXED, __HIP_MEMORY_SCOPE_AGENT
#define LDS_WAIT() asm volatile("s_waitcnt lgkmcnt(0)" ::: "memory")
#define VM_WAIT() asm volatile("s_waitcnt vmcnt(0)" ::: "memory")
__device__ __forceinline__ unsigned long long rt() { return __builtin_amdgcn_s_memrealtime(); }
__device__ __forceinline__ unsigned f2bf(float f) { unsigned u = __builtin_bit_cast(unsigned, f); return (u + 0x7fffu + ((u >> 16) & 1u)) >> 16; }
__device__ __forceinline__ unsigned pk2(float lo, float hi) { unsigned r; asm("v_cvt_pk_bf16_f32 %0, %1, %2" : "=v"(r) : "v"(lo), "v"(hi)); return r; }

#define XB_TMO      128
#define XB_XCNT(j)  (256  + 64 * (j))
#define XB_XSUB(j)  (1280 + 64 * (j))
#define XB_XGEN(j)  (2304 + 64 * (j))
#define XB_TOP      3328
#define XB_TOPGEN   3392
#define XCD_BAR_WORDS 3456
#define XB_SPIN_CAP (1u << 18)

__device__ __forceinline__ unsigned xb_ld(unsigned* p)              { return __hip_atomic_load(p, __ATOMIC_RELAXED, __HIP_MEMORY_SCOPE_AGENT); }
__device__ __forceinline__ unsigned xb_add(unsigned* p, unsigned v) { return __hip_atomic_fetch_add(p, v, __ATOMIC_RELAXED, __HIP_MEMORY_SCOPE_AGENT); }
__device__ __forceinline__ unsigned xb_xcc_id() { return (unsigned)__builtin_amdgcn_s_getreg((3 << 11) | 20) & 0xFu; }
#define XB_SPIN(cond, bar) do { unsigned _sp = 0; while (cond) { __builtin_amdgcn_s_sleep(1); \
    if ((++_sp & 255u) == 0u) { if (xb_ld(&(bar)[XB_TMO])) break; if (_sp > XB_SPIN_CAP) { atomicAdd(&(bar)[XB_TMO], 1u); break; } } } } while (0)

struct XcdBarrier {
    unsigned* bar; unsigned x;
    volatile LAS unsigned* st;
};

__device__ __forceinline__ XcdBarrier xcd_barrier_post(unsigned* bar, volatile LAS unsigned* st) {
    XcdBarrier b; b.bar = bar; b.x = xb_xcc_id(); b.st = st;
    if (threadIdx.x == 0) (void)xb_add(&bar[XB_XCNT(b.x)], 1u);
    return b;
}
__device__ __forceinline__ void xcd_barrier_complete(unsigned* bar, unsigned x, unsigned& nloc, unsigned& nx) {
    const unsigned G = gridDim.x * gridDim.y * gridDim.z;
    unsigned sum, cnt, mine, sp = 0u;
    for (;;) {
        sum = 0u; cnt = 0u; mine = 0u;
#pragma unroll
        for (unsigned j = 0; j < 16; ++j) { const unsigned c = xb_ld(&bar[XB_XCNT(j)]); sum += c; cnt += (c > 0u) ? 1u : 0u; mine = (j == x) ? c : mine; }
        if (sum == G) break;
        __builtin_amdgcn_s_sleep(1);
        if ((++sp & 255u) == 0u) { if (xb_ld(&bar[XB_TMO])) break; if (sp > XB_SPIN_CAP) { atomicAdd(&bar[XB_TMO], 1u); break; } }
    }
    nloc = mine > 0u ? mine : 1u; nx = cnt > 0u ? cnt : 1u;
}

__device__ __forceinline__ void xcd_barrier(const XcdBarrier& b) {
    asm volatile("s_waitcnt vmcnt(0)" ::: "memory");
    __syncthreads();
    if (threadIdx.x == 0) {
        unsigned* bar = b.bar;
        __builtin_amdgcn_s_waitcnt(0);
        unsigned nloc = b.st[0], nx = b.st[1];
        if (nloc == 0u) { xcd_barrier_complete(bar, b.x, nloc, nx); b.st[0] = nloc; b.st[1] = nx; }
        const unsigned old = xb_add(&bar[XB_XSUB(b.x)], 1u);
        const unsigned gen = old / nloc;
        if (old + 1u == (gen + 1u) * nloc) {
            __builtin_amdgcn_fence(__ATOMIC_RELEASE, "agent");
            asm volatile("s_waitcnt vmcnt(0)" ::: "memory");
            const unsigned og = xb_add(&bar[XB_TOP], 1u);
            const unsigned tg = og / nx;
            if (og + 1u == (tg + 1u) * nx) xb_add(&bar[XB_TOPGEN], 1u);
            else XB_SPIN(xb_ld(&bar[XB_TOPGEN]) == tg, bar);
            __builtin_amdgcn_fence(__ATOMIC_ACQUIRE, "agent");
            xb_add(&bar[XB_XGEN(b.x)], 1u);
            asm volatile("s_waitcnt vmcnt(0)" ::: "memory");
        } else {
            XB_SPIN(xb_ld(&bar[XB_XGEN(b.x)]) == gen, bar);
            __builtin_amdgcn_fence(__ATOMIC_ACQUIRE, "agent");
            asm volatile("s_waitcnt vmcnt(0)" ::: "memory");
        }
    }
    __syncthreads();
}

constexpr int NWAVES = 8;
#ifndef MK_N_LAUNCHES
#define MK_N_LAUNCHES 1
#endif
constexpr int N_PHASES = 8;
constexpr int BATCH = 2, SEQ = 8192, DM = 2048, M = BATCH * SEQ, NPROJ = 4096, FFN = 5632, NGU = 2 * FFN, NMOD = 6 * DM;
constexpr float EPS = 1e-6f;
constexpr size_t MiB = 1u << 20;
constexpr size_t WS_CTL = 0, CTL_ZERO_BYTES = 128 * 1024;
constexpr size_t WS_MOD = 32 * 1024;
constexpr size_t WS_SSQK = 1 * MiB;
constexpr size_t WS_SS2 = 2 * MiB;
constexpr size_t WS_CB = 2 * MiB + 256 * 1024;
constexpr size_t WS_WIN = 4 * MiB, WS_WGLU = 20 * MiB, WS_WOUT = 22 * MiB, WS_WGU = 30 * MiB, WS_WD = 74 * MiB;
constexpr size_t WS_SC_W1 = 96 * MiB, WS_SC_CM = 104 * MiB, WS_SC_KT = 112 * MiB, WS_SC_A32 = 113 * MiB;
constexpr size_t WS_R = 130 * MiB;
constexpr size_t WS_UG = WS_R, WS_Q = WS_R + 32 * MiB, WS_K = WS_R + 64 * MiB, WS_V = WS_R + 96 * MiB, WS_YG = WS_R + 128 * MiB, WS_ATT = WS_R + 160 * MiB;
constexpr size_t WS_H1 = WS_R + 192 * MiB, WS_A2 = WS_R, WS_T = WS_R + 64 * MiB;
constexpr size_t WS_MIXED = 386 * MiB;
constexpr size_t WS_HS = 114 * MiB, WS_WGU1 = 450 * MiB, WS_CIS = 494 * MiB, WS_AML = 502 * MiB, WS_END = 505 * MiB;
constexpr int CW_TMO = 0, CW_CODE = 1, CW_Q = 64, CW_MODDONE = 320, CW_BAR = 4096;

constexpr int RING_OFF = 0, RING_BYTES = 131072;
constexpr int LDS_BYTES = 163840;
constexpr int LDSCTL_OFF = LDS_BYTES - 512, MISC_OFF = LDSCTL_OFF + 320;

struct Frame {
    LAS unsigned char* lds;
    volatile LAS unsigned* MISC;
    gu32* ctl;
    int tid, lane, wave, vcu, G;
    const float* in[22]; float* out; unsigned char* ws;
};
__device__ __forceinline__ float wave_sum(float v) {
#pragma unroll
    for (int o = 1; o < 64; o <<= 1) v += __shfl_xor(v, o);
    return v;
}
__device__ __forceinline__ float wave_max(float v) {
#pragma unroll
    for (int o = 1; o < 64; o <<= 1) v = fmaxf(v, __shfl_xor(v, o));
    return v;
}
__device__ __forceinline__ void p0_transpose_item(const float* W, int K, int N, bf16* WT, int mode, LAS float* scr, int item, int lane) {
    const int nblk = N / 32, kb = item / nblk, nb = item % nblk, k0 = 64 * kb, n0 = 32 * nb;
    f32x4 tq[8];
    { const int r8 = lane >> 3, c4 = lane & 7;
#pragma unroll
      for (int j = 0; j < 8; ++j) tq[j] = NT_LOAD((const f32x4*)(W + (size_t)(k0 + 8 * j + r8) * N + n0 + 4 * c4));
#pragma unroll
      for (int j = 0; j < 8; ++j) { LAS float* sp = scr + (8 * j + r8) * 33 + 4 * c4; sp[0] = tq[j][0]; sp[1] = tq[j][1]; sp[2] = tq[j][2]; sp[3] = tq[j][3]; } }
    LDS_WAIT(); asm volatile("" ::: "memory");
    const int c = lane & 7;
#pragma unroll
    for (int j = 0; j < 4; ++j) { const int n = (lane >> 3) + 8 * j; const LAS float* s = scr + (8 * c) * 33 + n;
        v4u o; o.x = pk2(s[0 * 33], s[1 * 33]); o.y = pk2(s[2 * 33], s[3 * 33]); o.z = pk2(s[4 * 33], s[5 * 33]); o.w = pk2(s[6 * 33], s[7 * 33]);
        const int ng = n0 + n; const int row = mode == 0 ? ng : ((ng >> 7) * 256 + (ng & 127) + (mode == 2 ? 128 : 0));
        *(GAS v4u*)(WT + (size_t)row * K + k0 + 8 * c) = o; }
    LDS_WAIT(); asm volatile("" ::: "memory");
}
#ifndef LATE_TR
#define LATE_TR 1
#endif
__device__ __forceinline__ void p0_transposes(Frame& F);
__device__ __forceinline__ void p0_prologue(Frame& F) {
    const float* cin = F.in[1]; const float* w_ada = F.in[2]; const float* b_ada = F.in[3];
    float* mod = (float*)(F.ws + WS_MOD);
    {   LAS float* sbuf = (LAS float*)(F.lds + RING_OFF); LAS float* obuf = (LAS float*)(F.lds + RING_OFF + 1024);
        for (int it = blockIdx.x; it < 192; it += F.G) { const int kc = it / 6, cc = it % 6;
            if (F.tid < 128) { const int b = F.tid >> 6, kk = F.tid & 63; const float cv = cin[b * DM + kc * 64 + kk]; sbuf[b * 64 + kk] = cv / (1.0f + __expf(-cv)); }
            __syncthreads();
            const int col = cc * 2048 + F.tid * 4; f32x4 a0 = {0.f, 0.f, 0.f, 0.f}, a1 = {0.f, 0.f, 0.f, 0.f};
#pragma unroll 8
            for (int kk = 0; kk < 64; ++kk) { const f32x4 w = NT_LOAD((const f32x4*)(w_ada + (size_t)(kc * 64 + kk) * NMOD + col)); a0 += w * sbuf[kk]; a1 += w * sbuf[64 + kk]; }
            if (kc == 0) { const f32x4 bb = *(const f32x4*)(b_ada + col); a0 += bb; a1 += bb; }
#pragma unroll
            for (int e = 0; e < 4; ++e) { obuf[F.tid * 4 + e] = a0[e]; obuf[2048 + F.tid * 4 + e] = a1[e]; }
            __syncthreads();
#pragma unroll
            for (int j = 0; j < 4; ++j) { atomicAdd(mod + cc * 2048 + F.tid + 512 * j, obuf[F.tid + 512 * j]); atomicAdd(mod + NMOD + cc * 2048 + F.tid + 512 * j, obuf[2048 + F.tid + 512 * j]); }
            asm volatile("s_waitcnt vmcnt(0)" ::: "memory");
            __syncthreads();
            if (F.tid == 0) { __builtin_amdgcn_fence(__ATOMIC_RELEASE, "agent"); asm volatile("s_waitcnt vmcnt(0)" ::: "memory");
                              __hip_atomic_fetch_add((unsigned*)(F.ctl + CW_MODDONE), 1u, __ATOMIC_RELAXED, __HIP_MEMORY_SCOPE_AGENT); }
        } }
}
__device__ __forceinline__ void wait_mod_done(Frame& F) {
    if (F.tid == 0) { unsigned sp = 0;
        while (__hip_atomic_load((unsigned*)(F.ctl + CW_MODDONE), __ATOMIC_RELAXED, __HIP_MEMORY_SCOPE_AGENT) < 192u) { __builtin_amdgcn_s_sleep(2); if (++sp > (1u << 22)) break; }
        __builtin_amdgcn_fence(__ATOMIC_ACQUIRE, "agent"); asm volatile("s_waitcnt vmcnt(0)" ::: "memory"); }
    __syncthreads();
}
__device__ __forceinline__ void p0_rest(Frame& F) {
    {   f32x4* z = (f32x4*)(F.ws + WS_SSQK); const f32x4 zero = {0.f, 0.f, 0.f, 0.f};
        for (int i = F.vcu * 512 + F.tid; i < 16 * 16384 / 4; i += F.G * 512) z[i] = zero;
        f32x4* z2 = (f32x4*)(F.ws + WS_SS2);
        for (int i = F.vcu * 512 + F.tid; i < 16384 / 4; i += F.G * 512) z2[i] = zero;
        f32x4* z3 = (f32x4*)(F.ws + WS_CB);
        for (int i = F.vcu * 512 + F.tid; i < 2 * NGU / 4; i += F.G * 512) z3[i] = zero; }
    p0_transposes(F);
}
__device__ __forceinline__ void p0_transposes(Frame& F) {
    __syncthreads();
    LAS float* scr = (LAS float*)(F.lds + RING_OFF + F.wave * 16384);
    const int gw = F.vcu * NWAVES + F.wave, NGW = F.G * NWAVES;
    constexpr int I_IN = (DM / 64) * (NPROJ / 32), I_GLU = (1024 / 64) * (1024 / 32), I_OUT = (DM / 64) * (DM / 32), I_D = (FFN / 64) * (DM / 32);
    constexpr int NITEMS = LATE_TR ? I_IN : I_IN + I_GLU + I_OUT + I_D;
    for (int it = gw; it < NITEMS; it += NGW) {
        int r = it;
        if (r < I_IN) { p0_transpose_item(F.in[5], DM, NPROJ, (bf16*)(F.ws + WS_WIN), 0, scr, r, F.lane); continue; } r -= I_IN;
        if (r < I_GLU) { p0_transpose_item(F.in[14], 1024, 1024, (bf16*)(F.ws + WS_WGLU), 0, scr, r, F.lane); continue; } r -= I_GLU;
        if (r < I_OUT) { p0_transpose_item(F.in[17], DM, DM, (bf16*)(F.ws + WS_WOUT), 0, scr, r, F.lane); continue; } r -= I_OUT;
        p0_transpose_item(F.in[21], FFN, DM, (bf16*)(F.ws + WS_WD), 0, scr, r, F.lane);
    }
}
__device__ __forceinline__ void gu_item(Frame& F, int it, int lane) {
    LAS float* scr = (LAS float*)(F.lds + RING_OFF + F.wave * 16384); LAS float* shs = scr + 2176;
    const float* n2w = F.in[18]; float* cb = (float*)(F.ws + WS_CB); const float* mod = (const float*)(F.ws + WS_MOD);
    bf16* WT0 = (bf16*)(F.ws + WS_WGU); bf16* WT1 = (bf16*)(F.ws + WS_WGU1);
    constexpr int I_G = (DM / 64) * (FFN / 32);
    { const int up = it >= I_G; const int item = it - up * I_G; const float* W = up ? F.in[20] : F.in[19];
            const int nblk = FFN / 32, kb = item / nblk, nb = item % nblk, k0 = 64 * kb, n0 = 32 * nb;
            f32x4 tq[8]; const int r8 = lane >> 3, c4 = lane & 7;
#pragma unroll
            for (int j = 0; j < 8; ++j) tq[j] = NT_LOAD((const f32x4*)(W + (size_t)(k0 + 8 * j + r8) * FFN + n0 + 4 * c4));
            const int c = lane & 7;
            const f32x4 nw0 = *(const f32x4*)(n2w + k0 + 8 * c), nw1 = *(const f32x4*)(n2w + k0 + 8 * c + 4);
            const f32x4 sa0 = *(const f32x4*)(mod + 4 * DM + k0 + 8 * c), sa1 = *(const f32x4*)(mod + 4 * DM + k0 + 8 * c + 4);
            const f32x4 sb0 = *(const f32x4*)(mod + NMOD + 4 * DM + k0 + 8 * c), sb1 = *(const f32x4*)(mod + NMOD + 4 * DM + k0 + 8 * c + 4);
            shs[lane] = mod[3 * DM + k0 + lane]; shs[64 + lane] = mod[NMOD + 3 * DM + k0 + lane];
#pragma unroll
            for (int j = 0; j < 8; ++j) { LAS float* sp = scr + (8 * j + r8) * 33 + 4 * c4; sp[0] = tq[j][0]; sp[1] = tq[j][1]; sp[2] = tq[j][2]; sp[3] = tq[j][3]; }
            LDS_WAIT(); asm volatile("" ::: "memory");
            const f32x4 wa0 = nw0 * (sa0 + 1.0f), wa1 = nw1 * (sa1 + 1.0f), wb0 = nw0 * (sb0 + 1.0f), wb1 = nw1 * (sb1 + 1.0f);
#pragma unroll
            for (int j = 0; j < 4; ++j) { const int n = (lane >> 3) + 8 * j; const LAS float* sp = scr + (8 * c) * 33 + n;
                const float s0 = sp[0 * 33], s1 = sp[1 * 33], s2 = sp[2 * 33], s3 = sp[3 * 33], s4 = sp[4 * 33], s5 = sp[5 * 33], s6 = sp[6 * 33], s7 = sp[7 * 33];
                const int ng = n0 + n; const size_t row = (size_t)((ng >> 7) * 256 + (ng & 127) + up * 128);
                v4u o0, o1;
                o0.x = pk2(s0 * wa0[0], s1 * wa0[1]); o0.y = pk2(s2 * wa0[2], s3 * wa0[3]); o0.z = pk2(s4 * wa1[0], s5 * wa1[1]); o0.w = pk2(s6 * wa1[2], s7 * wa1[3]);
                o1.x = pk2(s0 * wb0[0], s1 * wb0[1]); o1.y = pk2(s2 * wb0[2], s3 * wb0[3]); o1.z = pk2(s4 * wb1[0], s5 * wb1[1]); o1.w = pk2(s6 * wb1[2], s7 * wb1[3]);
                *(GAS v4u*)(WT0 + row * DM + k0 + 8 * c) = o0; *(GAS v4u*)(WT1 + row * DM + k0 + 8 * c) = o1; }
            { const int n = lane & 31, b = lane >> 5; float a = 0.f;
#pragma unroll 16
              for (int k = 0; k < 64; ++k) a += shs[b * 64 + k] * scr[k * 33 + n];
              const int ng = n0 + n; atomicAdd(cb + b * NGU + (ng >> 7) * 256 + (ng & 127) + up * 128, a); }
            LDS_WAIT(); asm volatile("" ::: "memory"); }
}
constexpr int TR_IG = (DM / 64) * (FFN / 32), TR_GLU = (1024 / 64) * (1024 / 32), TR_OUT = (DM / 64) * (DM / 32), TR_D = (FFN / 64) * (DM / 32), TR_TOTAL = 2 * TR_IG + TR_GLU + TR_OUT + TR_D;
__device__ __forceinline__ void tr_wave_item(Frame& F, int it, int lane) {
    LAS float* scr = (LAS float*)(F.lds + RING_OFF + F.wave * 16384);
    if (it < 2 * TR_IG) { gu_item(F, it, lane); return; } it -= 2 * TR_IG;
    if (it < TR_GLU) { p0_transpose_item(F.in[14], 1024, 1024, (bf16*)(F.ws + WS_WGLU), 0, scr, it, lane); return; } it -= TR_GLU;
    if (it < TR_OUT) { p0_transpose_item(F.in[17], DM, DM, (bf16*)(F.ws + WS_WOUT), 0, scr, it, lane); return; } it -= TR_OUT;
    p0_transpose_item(F.in[21], FFN, DM, (bf16*)(F.ws + WS_WD), 0, scr, it, lane);
}
__device__ __forceinline__ void p1_norm1(Frame& F) {
    const int gw = F.vcu * NWAVES + F.wave, NGW = F.G * NWAVES;
    const float* x = F.in[0]; const float* n1w = F.in[4]; const float* mod = (const float*)(F.ws + WS_MOD);
    bf16* h1 = (bf16*)(F.ws + WS_H1);
    const bool blocked = (M % (2 * NGW)) == 0; const int rpw = M / NGW;
    const int m_begin = blocked ? gw * rpw : gw, m_end = blocked ? (gw + 1) * rpw : M, m_step = blocked ? 2 : 2 * NGW, m_pair = blocked ? 1 : NGW;
    {   const int ln = F.lane;
        f32x4 wv[8], shv[8]; int bcur = -1;
        f32x4 v0[8], v1[8];
        int m0 = m_begin;
        if (m0 < m_end) { const int m1 = (m0 + m_pair < M) ? m0 + m_pair : m0;
            const GAS f32x4* xr0 = (const GAS f32x4*)(x + (size_t)m0 * DM) + ln; const GAS f32x4* xr1 = (const GAS f32x4*)(x + (size_t)m1 * DM) + ln;
#pragma unroll
            for (int j = 0; j < 8; ++j) { v0[j] = NT_LOADA(xr0 + 64 * j); v1[j] = NT_LOADA(xr1 + 64 * j); } }
        for (; m0 < m_end; m0 += m_step) {
            const int m1 = m0 + m_pair; const bool has1 = m1 < M; const int b0 = m0 >> 13, b1 = (has1 ? m1 : m0) >> 13;
            if (b0 != bcur) { bcur = b0;
#pragma unroll
                for (int j = 0; j < 8; ++j) { const int col = 4 * ln + 256 * j; wv[j] = *(const f32x4*)(n1w + col) * (*(const f32x4*)(mod + b0 * NMOD + DM + col) + 1.0f); shv[j] = *(const f32x4*)(mod + b0 * NMOD + col); } }
            float s0 = 0.f, s1 = 0.f;
#pragma unroll
            for (int j = 0; j < 8; ++j) { s0 += (v0[j].x * v0[j].x + v0[j].y * v0[j].y) + (v0[j].z * v0[j].z + v0[j].w * v0[j].w); s1 += (v1[j].x * v1[j].x + v1[j].y * v1[j].y) + (v1[j].z * v1[j].z + v1[j].w * v1[j].w); }
            const float r0 = __builtin_amdgcn_rsqf(wave_sum(s0) * (1.0f / DM) + EPS), r1 = __builtin_amdgcn_rsqf(wave_sum(s1) * (1.0f / DM) + EPS);
            unsigned long long h0[8], h1v[8];
#pragma unroll
            for (int j = 0; j < 8; ++j) { const f32x4 ha = v0[j] * r0 * wv[j] + shv[j]; h0[j] = (unsigned long long)pk2(ha.x, ha.y) | ((unsigned long long)pk2(ha.z, ha.w) << 32); }
            if (b1 == b0) {
#pragma unroll
                for (int j = 0; j < 8; ++j) { const f32x4 hb = v1[j] * r1 * wv[j] + shv[j]; h1v[j] = (unsigned long long)pk2(hb.x, hb.y) | ((unsigned long long)pk2(hb.z, hb.w) << 32); }
            } else {
#pragma unroll
                for (int j = 0; j < 8; ++j) { const int col = 4 * ln + 256 * j; const f32x4 hb = v1[j] * r1 * (*(const f32x4*)(n1w + col) * (*(const f32x4*)(mod + b1 * NMOD + DM + col) + 1.0f)) + *(const f32x4*)(mod + b1 * NMOD + col);
                    h1v[j] = (unsigned long long)pk2(hb.x, hb.y) | ((unsigned long long)pk2(hb.z, hb.w) << 32); } }
            const int n0 = m0 + m_step;
            if (n0 < m_end) { const int n1 = (n0 + m_pair < M) ? n0 + m_pair : n0;
                const GAS f32x4* xr0 = (const GAS f32x4*)(x + (size_t)n0 * DM) + ln; const GAS f32x4* xr1 = (const GAS f32x4*)(x + (size_t)n1 * DM) + ln;
#pragma unroll
                for (int j = 0; j < 8; ++j) { v0[j] = NT_LOADA(xr0 + 64 * j); v1[j] = NT_LOADA(xr1 + 64 * j); } }
            asm volatile("" ::: "memory");
            GAS unsigned long long* o0 = (GAS unsigned long long*)(h1 + (size_t)m0 * DM) + ln; GAS unsigned long long* o1 = (GAS unsigned long long*)(h1 + (size_t)(has1 ? m1 : m0) * DM) + ln;
#pragma unroll
            for (int j = 0; j < 8; ++j) { o0[64 * j] = h0[j]; if (has1) o1[64 * j] = h1v[j]; }
            asm volatile("" ::: "memory");
        } }
    if (!LATE_TR) for (int it = gw; it < 2 * TR_IG; it += NGW) gu_item(F, it, F.lane);
}
__device__ __forceinline__ float gelu_tanh(float y) { const float y2 = y * y; const float w = y * (-2.302208198f - 0.1029432397f * y2);
    return y * __builtin_amdgcn_rcpf(1.0f + __builtin_amdgcn_exp2f(w)); }
__device__ __forceinline__ void p3_ssm_naive(Frame& F) {
    if (F.wave == 0) {
        const bf16* ug = (const bf16*)(F.ws + WS_UG); bf16* yg = (bf16*)(F.ws + WS_YG);
        for (int it = blockIdx.x; it < 128; it += F.G) { const int b = it >> 6, g = it & 63, n = F.lane;
            const float dt = expf(F.in[8][g]), are = F.in[6][g * 64 + n], aim = F.in[7][g * 64 + n];
            const float mag = expf(are * dt), abr = mag * cosf(aim * dt), abi = mag * sinf(aim * dt);
            const float nre = abr - 1.0f, nim = abi, den = are * are + aim * aim;
            const float zre = (nre * are + nim * aim) / den, zim = (nim * are - nre * aim) / den;
            float bbr[16], bbi[16], cre[16], cim[16];
#pragma unroll
            for (int c = 0; c < 16; ++c) { const float br = F.in[9][(g * 64 + n) * 16 + c], bi = F.in[10][(g * 64 + n) * 16 + c];
                bbr[c] = zre * br - zim * bi; bbi[c] = zre * bi + zim * br;
                cre[c] = F.in[11][(g * 16 + c) * 64 + n]; cim[c] = F.in[12][(g * 16 + c) * 64 + n]; }
            const float dl = F.in[13][g * 16 + (F.lane & 15)];
            float hr = 0.f, hi = 0.f;
            const bf16* up = ug + (size_t)((b * 64 + g) * 8192) * 16;
            for (int t = 0; t < SEQ; ++t) {
                const v4u w0 = *(const v4u*)(up + (size_t)t * 16), w1 = *(const v4u*)(up + (size_t)t * 16 + 8);
                const float u[16] = {__uint_as_float(w0.x << 16), __uint_as_float(w0.x & 0xffff0000u), __uint_as_float(w0.y << 16), __uint_as_float(w0.y & 0xffff0000u),
                                     __uint_as_float(w0.z << 16), __uint_as_float(w0.z & 0xffff0000u), __uint_as_float(w0.w << 16), __uint_as_float(w0.w & 0xffff0000u),
                                     __uint_as_float(w1.x << 16), __uint_as_float(w1.x & 0xffff0000u), __uint_as_float(w1.y << 16), __uint_as_float(w1.y & 0xffff0000u),
                                     __uint_as_float(w1.z << 16), __uint_as_float(w1.z & 0xffff0000u), __uint_as_float(w1.w << 16), __uint_as_float(w1.w & 0xffff0000u)};
                float bur = 0.f, bui = 0.f;
#pragma unroll
                for (int c = 0; c < 16; ++c) { bur += bbr[c] * u[c]; bui += bbi[c] * u[c]; }
                const float nr = abr * hr - abi * hi + bur, ni = abr * hi + abi * hr + bui; hr = nr; hi = ni;
                float yv = 0.f, ul = 0.f;
#pragma unroll
                for (int c = 0; c < 16; ++c) { const float p = wave_sum(hr * cre[c] - hi * cim[c]); if ((F.lane & 15) == c) { yv = p; ul = u[c]; } }
                yv += dl * ul;
                if (F.lane < 16) { const float gl = gelu_tanh(yv); yg[(size_t)(b * SEQ + t) * 1024 + g * 16 + F.lane] = (bf16)f2bf(gl); }
            } }
    }
}
__device__ __forceinline__ void p3_attn_naive(Frame& F) {
    const int gw = F.vcu * NWAVES + F.wave, NGW = F.G * NWAVES;
    const bf16* qb = (const bf16*)(F.ws + WS_Q); const bf16* kb = (const bf16*)(F.ws + WS_K); const bf16* vb = (const bf16*)(F.ws + WS_V);
    const float* ssqk = (const float*)(F.ws + WS_SSQK); bf16* mixed = (bf16*)(F.ws + WS_MIXED);
    LAS float* qw = (LAS float*)(F.lds + RING_OFF + F.wave * 1024);
    const float wq0 = F.in[15][2 * F.lane], wq1 = F.in[15][2 * F.lane + 1], wk0 = F.in[16][2 * F.lane], wk1 = F.in[16][2 * F.lane + 1];
    for (int it = gw; it < M * 8; it += NGW) { const int h = it & 7, bt = it >> 3, t = bt & (SEQ - 1), b = bt >> 13;
        const float slope = exp2f(-(float)(h + 1));
        const unsigned qraw = *(const unsigned*)(qb + (size_t)bt * 1024 + h * 128 + 2 * F.lane);
        const float rq = 1.0f / sqrtf(ssqk[(size_t)h * 16384 + bt] * (1.0f / 128.0f) + EPS) * 0.08838834764831845f;
        asm volatile("s_waitcnt lgkmcnt(0)" ::: "memory");
        qw[2 * F.lane] = __uint_as_float(qraw << 16) * rq * wq0 * wk0; qw[2 * F.lane + 1] = __uint_as_float(qraw & 0xffff0000u) * rq * wq1 * wk1;
        asm volatile("s_waitcnt lgkmcnt(0)" ::: "memory");
        float sc[7]; int kt[7]; float mx = -1e30f;
#pragma unroll
        for (int i = 0; i < 7; ++i) { const int p = F.lane + 64 * i; const int br = p / 129, j = p - br * 129; const int dil = br == 0 ? 1 : (br == 1 ? 4 : 16);
            const int kk = t - dil * j; const bool valid = (p < 387) && (kk >= 0); kt[i] = valid ? kk : -1; sc[i] = -1e30f;
            if (valid) { const size_t kr = (size_t)(b * SEQ + kk);
                const v4u* kp = (const v4u*)(kb + kr * 1024 + h * 128); float d = 0.f;
#pragma unroll
                for (int c = 0; c < 16; ++c) { const v4u w = kp[c]; const LAS float* qq = qw + 8 * c;
                    d += __uint_as_float(w.x << 16) * qq[0] + __uint_as_float(w.x & 0xffff0000u) * qq[1] + __uint_as_float(w.y << 16) * qq[2] + __uint_as_float(w.y & 0xffff0000u) * qq[3]
                       + __uint_as_float(w.z << 16) * qq[4] + __uint_as_float(w.z & 0xffff0000u) * qq[5] + __uint_as_float(w.w << 16) * qq[6] + __uint_as_float(w.w & 0xffff0000u) * qq[7]; }
                const float rk = 1.0f / sqrtf(ssqk[(size_t)(8 + h) * 16384 + kr] * (1.0f / 128.0f) + EPS);
                sc[i] = d * rk - slope * (float)(dil * j); mx = fmaxf(mx, sc[i]); } }
        mx = wave_max(mx);
        float ls = 0.f;
#pragma unroll
        for (int i = 0; i < 7; ++i) { sc[i] = kt[i] >= 0 ? __expf(sc[i] - mx) : 0.f; ls += sc[i]; }
        ls = wave_sum(ls);
        float o0 = 0.f, o1 = 0.f;
#pragma unroll
        for (int i = 0; i < 7; ++i)
            for (int src = 0; src < 64; ++src) { const float p = __shfl(sc[i], src); const int kk = __shfl(kt[i], src);
                if (kk >= 0) { const unsigned vv = *(const unsigned*)(vb + (size_t)(b * SEQ + kk) * 1024 + h * 128 + 2 * F.lane); o0 += p * __uint_as_float(vv << 16); o1 += p * __uint_as_float(vv & 0xffff0000u); } }
        const float rl = 1.0f / ls;
        *(unsigned*)(mixed + (size_t)bt * 2048 + 1024 + h * 128 + 2 * F.lane) = pk2(o0 * rl, o1 * rl);
    }
}


namespace att {
typedef short bf16x8 __attribute__((ext_vector_type(8)));
typedef short s16x4 __attribute__((ext_vector_type(4)));
typedef float f32x16 __attribute__((ext_vector_type(16)));
typedef float f32x2 __attribute__((ext_vector_type(2)));
typedef unsigned u32x4 __attribute__((ext_vector_type(4)));
typedef short v4i16_t __attribute__((ext_vector_type(4)));
constexpr int WAVE_LDS = 17408;
constexpr int WQK_OFF = 162816;
__device__ __forceinline__ int crow(int r, int hi) { return (r & 3) + 8 * (r >> 2) + 4 * hi; }
__device__ __forceinline__ int v_st(int k, int c) { const int kk = (k & ~0xC) | ((k & 4) << 1) | ((k & 8) >> 1); return ((kk >> 3) * 4 + (c >> 5)) * 512 + ((kk & 7) * 32 + (c & 31)) * 2; }
__device__ __forceinline__ int v_rd_base(int lane) { return ((lane & 3) << 3) | (((lane >> 2) & 3) << 6) | (((lane >> 4) & 1) << 5) | (((lane >> 5) & 1) << 8); }
constexpr int v_rd_off(int d0, int ks, int half) { return d0 * 512 + ks * 4096 + half * 2048; }
__device__ __forceinline__ unsigned cvtpk(float lo, float hi) { unsigned r; asm volatile("v_cvt_pk_bf16_f32 %0, %1, %2" : "=v"(r) : "v"(lo), "v"(hi)); return r; }
__device__ __forceinline__ s16x4 vtr(const LAS char* p) { return __builtin_bit_cast(s16x4, __builtin_amdgcn_ds_read_tr16_b64_v4i16((LAS v4i16_t*)p)); }

struct Ptrs { const bf16* q; const bf16* k; const bf16* v; const float* ssqk; bf16* ao; float* aml; unsigned* probe; };

__device__ __forceinline__ void task(const Ptrs& T, int br, int b, int h, int res, int Pq0, LAS char* wl, const LAS float* wqk, int lane) {
    const int r32 = lane & 31, hi = lane >> 5;
    const int dil = br == 0 ? 1 : (br == 1 ? 4 : 16);
    const size_t rowbase = (size_t)b * SEQ;
    const float* ssq = T.ssqk + (size_t)h * 16384 + rowbase; const float* ssk = T.ssqk + (size_t)(8 + h) * 16384 + rowbase;
    LAS float* rkb = (LAS float*)(wl + 16384); LAS float* lib = rkb + 160;
#pragma unroll
    for (int i = 0; i < 3; ++i) { const int kp = 64 * i + lane; if (kp < 160) { int P = Pq0 - 128 + kp; P = P < 0 ? 0 : P; rkb[kp] = 1.0f / sqrtf(ssk[dil * P + res] * (1.0f / 128.0f) + EPS); } }
    const int tq = dil * (Pq0 + r32) + res;
    const float rq = (0.08838834764831845f * 1.4426950408889634f) / sqrtf(ssq[tq] * (1.0f / 128.0f) + EPS);
    bf16x8 qr[8];
    { const bf16* qp = T.q + (rowbase + tq) * 1024 + h * 128 + 8 * hi;
#pragma unroll
      for (int ds = 0; ds < 8; ++ds) { const u32x4 w = *(const u32x4*)(qp + 16 * ds);
          const f32x4 wa = *(const LAS f32x4*)(wqk + 16 * ds + 8 * hi), wb = *(const LAS f32x4*)(wqk + 16 * ds + 8 * hi + 4);
          u32x4 o; o.x = cvtpk(__uint_as_float(w.x << 16) * rq * wa[0], __uint_as_float(w.x & 0xffff0000u) * rq * wa[1]);
          o.y = cvtpk(__uint_as_float(w.y << 16) * rq * wa[2], __uint_as_float(w.y & 0xffff0000u) * rq * wa[3]);
          o.z = cvtpk(__uint_as_float(w.z << 16) * rq * wb[0], __uint_as_float(w.z & 0xffff0000u) * rq * wb[1]);
          o.w = cvtpk(__uint_as_float(w.w << 16) * rq * wb[2], __uint_as_float(w.w & 0xffff0000u) * rq * wb[3]);
          qr[ds] = __builtin_bit_cast(bf16x8, o); } }
    f32x16 p[5];
    bf16x8 kfa[8], kfb[8];
#define ATT_KLOAD(KF, t_) do { int P = Pq0 - 128 + 32 * (t_) + r32; P = P < 0 ? 0 : P; const bf16* kp = T.k + (rowbase + dil * P + res) * 1024 + h * 128 + 8 * hi; \
        _Pragma("unroll") for (int ds = 0; ds < 8; ++ds) KF[ds] = *(const bf16x8*)(kp + 16 * ds); } while (0)
#define ATT_QK(KF, t_) do { f32x16 a = {}; _Pragma("unroll") for (int ds = 0; ds < 8; ++ds) a = __builtin_amdgcn_mfma_f32_32x32x16_bf16(KF[ds], qr[ds], a, 0, 0, 0); p[t_] = a; } while (0)
    ATT_KLOAD(kfa, 0); asm volatile("" ::: "memory");
    ATT_KLOAD(kfb, 1); asm volatile("" ::: "memory"); ATT_QK(kfa, 0);
    ATT_KLOAD(kfa, 2); asm volatile("" ::: "memory"); ATT_QK(kfb, 1);
    ATT_KLOAD(kfb, 3); asm volatile("" ::: "memory"); ATT_QK(kfa, 2);
    ATT_KLOAD(kfa, 4); asm volatile("" ::: "memory"); ATT_QK(kfb, 3);
    ATT_QK(kfa, 4);
#undef ATT_KLOAD
#undef ATT_QK
    const float cb = exp2f(-(float)(h + 1)) * (float)dil * 1.4426950408889634f;
    const float NEG = -__builtin_inff();
    float mx = NEG;
#pragma unroll
    for (int t = 0; t < 5; ++t) {
        f32x4 rk4[4];
#pragma unroll
        for (int g4 = 0; g4 < 4; ++g4) rk4[g4] = *(const LAS f32x4*)(rkb + 32 * t + 8 * g4 + 4 * hi);
#pragma unroll
        for (int r = 0; r < 16; ++r) { const int kk = (r & 3) + 8 * (r >> 2) + 4 * hi;
            const float s = p[t][r] * rk4[r >> 2][r & 3] + cb * (float)(kk + 32 * t - 128 - r32);
            bool valid = (Pq0 - 128 + 32 * t + kk) >= 0;
            if (t == 0) valid = valid && (kk >= r32);
            if (t == 4) valid = valid && (kk <= r32);
            const float sv = valid ? s : NEG; p[t][r] = sv; mx = fmaxf(mx, sv); } }
    { auto rr = __builtin_amdgcn_permlane32_swap(__float_as_uint(mx), __float_as_uint(mx), false, false); mx = fmaxf(__uint_as_float(rr[0]), __uint_as_float(rr[1])); }
    float ls = 0.f;
    bf16x8 pa[5][2];
#define ATT_PK4(P, B_, OUT) do { unsigned a0 = cvtpk(P[B_ + 0], P[B_ + 1]), a1 = cvtpk(P[B_ + 2], P[B_ + 3]); unsigned b0 = cvtpk(P[B_ + 4], P[B_ + 5]), b1 = cvtpk(P[B_ + 6], P[B_ + 7]); \
        auto r0 = __builtin_amdgcn_permlane32_swap(a0, b0, false, false); auto r1 = __builtin_amdgcn_permlane32_swap(a1, b1, false, false); \
        u32x4 w = {r0[0], r1[0], r0[1], r1[1]}; OUT = __builtin_bit_cast(bf16x8, w); } while (0)
#pragma unroll
    for (int t = 0; t < 5; ++t) {
#pragma unroll
        for (int r = 0; r < 16; ++r) { const float e = __builtin_amdgcn_exp2f(p[t][r] - mx); p[t][r] = e; ls += e; }
        ATT_PK4(p[t], 0, pa[t][0]); ATT_PK4(p[t], 8, pa[t][1]); }
#undef ATT_PK4
    { auto rr = __builtin_amdgcn_permlane32_swap(__float_as_uint(ls), __float_as_uint(ls), false, false); ls = __uint_as_float(rr[0]) + __uint_as_float(rr[1]); }
    f32x16 o[4] = {};
    const int sr = lane >> 4, sc = (lane & 15) * 8;
    const LAS char* vrd = wl + v_rd_base(lane);
    u32x4 vs[8];
#define ATT_VLOAD(t_) do { _Pragma("unroll") for (int i = 0; i < 8; ++i) { int P = Pq0 - 128 + 32 * (t_) + sr + 4 * i; P = P < 0 ? 0 : P; \
        vs[i] = *(const u32x4*)(T.v + (rowbase + dil * P + res) * 1024 + h * 128 + sc); } } while (0)
#define ATT_VWRITE(t_) do { _Pragma("unroll") for (int i = 0; i < 8; ++i) *(LAS u32x4*)(wl + ((t_) & 1) * 8192 + v_st(sr + 4 * i, sc)) = vs[i]; } while (0)
    ATT_VLOAD(0); ATT_VWRITE(0);
    __builtin_amdgcn_sched_barrier(0);
#pragma unroll
    for (int t = 0; t < 5; ++t) {
        if (t + 1 < 5) ATT_VLOAD(t + 1);
        const bf16x8 pa0 = pa[t][0], pa1 = pa[t][1];
        const LAS char* vb = vrd + (t & 1) * 8192;
#pragma unroll
        for (int d0 = 0; d0 < 4; ++d0) {
            const s16x4 l0 = vtr(vb + v_rd_off(d0, 0, 0)), h0 = vtr(vb + v_rd_off(d0, 0, 1)), l1 = vtr(vb + v_rd_off(d0, 1, 0)), h1 = vtr(vb + v_rd_off(d0, 1, 1));
            o[d0] = __builtin_amdgcn_mfma_f32_32x32x16_bf16(pa0, (bf16x8){l0[0], l0[1], l0[2], l0[3], h0[0], h0[1], h0[2], h0[3]}, o[d0], 0, 0, 0);
            o[d0] = __builtin_amdgcn_mfma_f32_32x32x16_bf16(pa1, (bf16x8){l1[0], l1[1], l1[2], l1[3], h1[0], h1[1], h1[2], h1[3]}, o[d0], 0, 0, 0); }
        if (t + 1 < 5) ATT_VWRITE(t + 1);
        __builtin_amdgcn_sched_barrier(0);
    }
#undef ATT_VLOAD
#undef ATT_VWRITE
    if (hi == 0) { lib[r32] = ls; *(f32x2*)(T.aml + ((size_t)br * M + rowbase + tq) * 16 + 2 * h) = (f32x2){mx, ls}; }
    bf16* ao = T.ao + (size_t)br * M * 1024;
#pragma unroll
    for (int r = 0; r < 16; ++r) { const int orow = crow(r, hi); const float rl = 1.0f / lib[orow];
        bf16* op = ao + (rowbase + dil * (Pq0 + orow) + res) * 1024 + h * 128 + r32;
#pragma unroll
        for (int d0 = 0; d0 < 4; ++d0) { const float v = o[d0][r] * rl; const float vn = __shfl_xor(v, 1);
            if ((r32 & 1) == 0) *(unsigned*)(op + d0 * 32) = cvtpk(v, vn); } }
}
__device__ __forceinline__ void unit(const Ptrs& T, int u, LAS char* lds, int wave, int lane) {
    const int br = u >> 9, rem = u & 511, bh = rem >> 5, x = rem & 31;
    const int upr = br == 0 ? 32 : (br == 1 ? 8 : 2);
    const int res = x / upr, pb8 = x % upr;
    task(T, br, bh >> 3, bh & 7, res, 32 * (pb8 * 8 + wave), lds + wave * WAVE_LDS, (const LAS float*)(lds + WQK_OFF), lane);
}

constexpr int CO_RK = 98304, CO_LI = CO_RK + 1536, CO_OST = CO_LI + 1024;
#ifndef ATT_PF
#define ATT_PF 8
#endif
#define ATT_KSWZ(row, colB) ((row) * 256 + ((colB) ^ (((row) & 7) << 4)))
struct UnitId { int br, b, h, res, Pu0, dil; };
__device__ __forceinline__ UnitId decode(int u) { UnitId d; d.br = u >> 9; const int rem = u & 511, bh = rem >> 5, x = rem & 31; const int upr = d.br == 0 ? 32 : (d.br == 1 ? 8 : 2);
    d.b = bh >> 3; d.h = bh & 7; d.res = x / upr; d.Pu0 = 256 * (x % upr); d.dil = d.br == 0 ? 1 : (d.br == 1 ? 4 : 16); return d; }
template <int I0 = 0, int I1 = 12>
__device__ __forceinline__ void stage_load(u32x4 (&st)[12], const bf16* base, const UnitId& d, int tid) {
    const bf16* p = base + ((size_t)d.b * SEQ) * 1024 + d.h * 128 + (tid & 15) * 8;
#pragma unroll
    for (int i = I0; i < I1; ++i) { int P = d.Pu0 - 128 + (tid >> 4) + 32 * i; P = P < 0 ? 0 : P; st[i] = NT_LOADKV((const u32x4*)(p + (size_t)(d.dil * P + d.res) * 1024)); }
}
__device__ __forceinline__ void stage_write_k(const u32x4 (&st)[12], LAS char* lds, int tid) {
    const int r = tid >> 4, cb = (tid & 15) * 16;
#pragma unroll
    for (int i = 0; i < 12; ++i) *(LAS u32x4*)(lds + i * 8192 + ATT_KSWZ(r, cb)) = st[i];
}
__device__ __forceinline__ void stage_write_v(const u32x4 (&st)[12], LAS char* lds, int tid) {
    const int r = tid >> 4, c = (tid & 15) * 8;
#pragma unroll
    for (int i = 0; i < 12; ++i) *(LAS u32x4*)(lds + i * 8192 + v_st(r, c)) = st[i];
}
struct Carry { u32x4 kst[12]; float rk_raw, ssq_raw; };
__device__ __forceinline__ void carry_load_rest(Carry& c, const Ptrs& T, const UnitId& d, int tid, int wave, int lane) {
    const size_t rowbase = (size_t)d.b * SEQ; const int r32 = lane & 31;
    const int tq = d.dil * (d.Pu0 + 32 * wave + r32) + d.res;
    c.ssq_raw = T.ssqk[(size_t)d.h * 16384 + rowbase + tq];
    int P = d.Pu0 - 128 + (tid < 384 ? tid : 0); P = P < 0 ? 0 : P;
    c.rk_raw = T.ssqk[(size_t)(8 + d.h) * 16384 + rowbase + d.dil * P + d.res];
}
template <class Fetch>
__device__ __forceinline__ int unit_co(const Ptrs& T, int u, Carry& c, LAS char* lds, int tid, int wave, int lane, int n_ssm, int n_total, const Fetch& fetch_next) {
#ifdef PROBE_ATT
    unsigned long long ts_[8]; int nst_ = 0;
#define ATT_STAMP() do { __builtin_amdgcn_sched_barrier(0); ts_[nst_++] = __builtin_amdgcn_s_memrealtime(); __builtin_amdgcn_sched_barrier(0); } while (0)
#else
#define ATT_STAMP() do {} while (0)
#endif
    ATT_STAMP();
    const UnitId d = decode(u);
    const unsigned nxt_raw = fetch_next.issue();
    const int r32 = lane & 31, hi = lane >> 5;
    const size_t rowbase = (size_t)d.b * SEQ;
    const LAS float* wqk = (const LAS float*)(lds + WQK_OFF);
    LAS float* rkb = (LAS float*)(lds + CO_RK); LAS float* lib = (LAS float*)(lds + CO_LI) + wave * 32;
    const int Pq0 = d.Pu0 + 32 * wave;
    const int tq = d.dil * (Pq0 + r32) + d.res;
    stage_load<8, 12>(c.kst, T.k, d, tid);
    stage_write_k(c.kst, lds, tid);
    __builtin_amdgcn_sched_barrier(0);
    u32x4 qraw[8];
    { const bf16* qp = T.q + (rowbase + tq) * 1024 + d.h * 128 + 8 * hi;
#pragma unroll
      for (int ds = 0; ds < 8; ++ds) qraw[ds] = *(const u32x4*)(qp + 16 * ds); }
    if (tid < 384) rkb[tid] = 1.0f / sqrtf(c.rk_raw * (1.0f / 128.0f) + EPS);
    __syncthreads();
    ATT_STAMP();
    const float rq = (0.08838834764831845f * 1.4426950408889634f) / sqrtf(c.ssq_raw * (1.0f / 128.0f) + EPS);
    bf16x8 qr[8];
#pragma unroll
    for (int ds = 0; ds < 8; ++ds) { const u32x4 w = qraw[ds];
        const f32x4 wa = *(const LAS f32x4*)(wqk + 16 * ds + 8 * hi), wb = *(const LAS f32x4*)(wqk + 16 * ds + 8 * hi + 4);
        u32x4 o; o.x = cvtpk(__uint_as_float(w.x << 16) * rq * wa[0], __uint_as_float(w.x & 0xffff0000u) * rq * wa[1]);
        o.y = cvtpk(__uint_as_float(w.y << 16) * rq * wa[2], __uint_as_float(w.y & 0xffff0000u) * rq * wa[3]);
        o.z = cvtpk(__uint_as_float(w.z << 16) * rq * wb[0], __uint_as_float(w.z & 0xffff0000u) * rq * wb[1]);
        o.w = cvtpk(__uint_as_float(w.w << 16) * rq * wb[2], __uint_as_float(w.w & 0xffff0000u) * rq * wb[3]);
        qr[ds] = __builtin_bit_cast(bf16x8, o); }
    f32x16 p[5];
    { const LAS char* kw = lds + wave * 8192;
      const LAS char* kb0 = kw + ATT_KSWZ(r32, (0 * 16 + hi * 8) * 2); const LAS char* kb1 = kw + ATT_KSWZ(r32, (1 * 16 + hi * 8) * 2);
      const LAS char* kb2 = kw + ATT_KSWZ(r32, (2 * 16 + hi * 8) * 2); const LAS char* kb3 = kw + ATT_KSWZ(r32, (3 * 16 + hi * 8) * 2);
#pragma unroll
      for (int t = 0; t < 5; ++t) { f32x16 a = {};
#pragma unroll
          for (int ds = 0; ds < 8; ++ds) { const LAS char* kp = ((ds & 3) == 0 ? kb0 : (ds & 3) == 1 ? kb1 : (ds & 3) == 2 ? kb2 : kb3) + t * 8192 + (ds >> 2) * 128;
              a = __builtin_amdgcn_mfma_f32_32x32x16_bf16(*(const LAS bf16x8*)kp, qr[ds], a, 0, 0, 0); }
          p[t] = a; if (t & 1) __builtin_amdgcn_sched_barrier(0); } }
    ATT_STAMP();
    u32x4 vst[12];
    stage_load(vst, T.v, d, tid);
    __builtin_amdgcn_sched_barrier(0);
    const float cb = exp2f(-(float)(d.h + 1)) * (float)d.dil * 1.4426950408889634f;
    const float NEG = -__builtin_inff();
    const float bl = cb * (float)(4 * hi - 128 - r32);
    const bool edge = Pq0 < 128;
    float mx = NEG;
#pragma unroll
    for (int t = 0; t < 5; ++t) {
        f32x4 rk4[4];
#pragma unroll
        for (int g4 = 0; g4 < 4; ++g4) rk4[g4] = *(const LAS f32x4*)(rkb + 32 * (wave + t) + 8 * g4 + 4 * hi);
        const float bt = bl + cb * (float)(32 * t);
#pragma unroll
        for (int r = 0; r < 16; ++r) { const int k0 = (r & 3) + 8 * (r >> 2);
            float s = __builtin_fmaf(p[t][r], rk4[r >> 2][r & 3], __builtin_fmaf(cb, (float)k0, bt));
            if (t == 0) s = (k0 + 4 * hi >= r32) ? s : NEG;
            if (t == 4) s = (k0 + 4 * hi <= r32) ? s : NEG;
            p[t][r] = s; }
        if (edge) {
#pragma unroll
            for (int r = 0; r < 16; ++r) { const int kk = (r & 3) + 8 * (r >> 2) + 4 * hi; if (Pq0 - 128 + 32 * t + kk < 0) p[t][r] = NEG; } }
#pragma unroll
        for (int r = 0; r < 16; r += 2) mx = __builtin_fmaxf(__builtin_fmaxf(mx, p[t][r]), p[t][r + 1]); }
    { auto rr = __builtin_amdgcn_permlane32_swap(__float_as_uint(mx), __float_as_uint(mx), false, false); mx = fmaxf(__uint_as_float(rr[0]), __uint_as_float(rr[1])); }
    float ls = 0.f;
    bf16x8 pa[5][2];
#define ATT_PK4(P, B_, OUT) do { unsigned a0 = cvtpk(P[B_ + 0], P[B_ + 1]), a1 = cvtpk(P[B_ + 2], P[B_ + 3]); unsigned b0 = cvtpk(P[B_ + 4], P[B_ + 5]), b1 = cvtpk(P[B_ + 6], P[B_ + 7]); \
        auto r0 = __builtin_amdgcn_permlane32_swap(a0, b0, false, false); auto r1 = __builtin_amdgcn_permlane32_swap(a1, b1, false, false); \
        u32x4 w = {r0[0], r1[0], r0[1], r1[1]}; OUT = __builtin_bit_cast(bf16x8, w); } while (0)
#pragma unroll
    for (int t = 0; t < 5; ++t) {
#pragma unroll
        for (int r = 0; r < 16; ++r) { const float e = __builtin_amdgcn_exp2f(p[t][r] - mx); p[t][r] = e; ls += e; }
        ATT_PK4(p[t], 0, pa[t][0]); ATT_PK4(p[t], 8, pa[t][1]); }
#undef ATT_PK4
    { auto rr = __builtin_amdgcn_permlane32_swap(__float_as_uint(ls), __float_as_uint(ls), false, false); ls = __uint_as_float(rr[0]) + __uint_as_float(rr[1]); }
    ATT_STAMP();
    __syncthreads();
    stage_write_v(vst, lds, tid);
    const int nxt = fetch_next.publish(nxt_raw);
    const bool nxt_valid = nxt < n_total;
    ATT_STAMP();
    __builtin_amdgcn_sched_barrier(0);
    f32x16 o[4] = {};
    { const LAS char* vrd = lds + wave * 8192 + v_rd_base(lane);
#pragma unroll
      for (int t = 0; t < 5; ++t) { const LAS char* vb = vrd + t * 8192;
#pragma unroll
          for (int d0 = 0; d0 < 4; ++d0) {
              const s16x4 l0 = vtr(vb + v_rd_off(d0, 0, 0)), h0 = vtr(vb + v_rd_off(d0, 0, 1)), l1 = vtr(vb + v_rd_off(d0, 1, 0)), h1 = vtr(vb + v_rd_off(d0, 1, 1));
              o[d0] = __builtin_amdgcn_mfma_f32_32x32x16_bf16(pa[t][0], (bf16x8){l0[0], l0[1], l0[2], l0[3], h0[0], h0[1], h0[2], h0[3]}, o[d0], 0, 0, 0);
              o[d0] = __builtin_amdgcn_mfma_f32_32x32x16_bf16(pa[t][1], (bf16x8){l1[0], l1[1], l1[2], l1[3], h1[0], h1[1], h1[2], h1[3]}, o[d0], 0, 0, 0); }
          __builtin_amdgcn_sched_barrier(0);
          if (t == 1 && nxt_valid) { const UnitId dn = decode((nxt - n_ssm) % 1536); stage_load<0, 4>(c.kst, T.k, dn, tid); __builtin_amdgcn_sched_barrier(0); }
          if (t == 3 && nxt_valid) { const UnitId dn = decode((nxt - n_ssm) % 1536); stage_load<4, 8>(c.kst, T.k, dn, tid); __builtin_amdgcn_sched_barrier(0); } } }
    ATT_STAMP();
    if (hi == 0) { lib[r32] = ls; *(f32x2*)(T.aml + ((size_t)d.br * M + rowbase + tq) * 16 + 2 * d.h) = (f32x2){mx, ls}; }
    bf16* ao = T.ao + (size_t)d.br * M * 1024;
    float rl[16];
#pragma unroll
    for (int r = 0; r < 16; ++r) rl[r] = 1.0f / lib[crow(r, hi)];
    LAS unsigned short* stg = (LAS unsigned short*)(lds + CO_OST + wave * 4608);
#pragma unroll
    for (int hh = 0; hh < 2; ++hh) {
#pragma unroll
        for (int r = 0; r < 16; ++r) { const int orow = crow(r, hi);
            const unsigned w2 = pk2(o[2 * hh][r] * rl[r], o[2 * hh + 1][r] * rl[r]);
            stg[orow * 72 + r32] = (unsigned short)w2; stg[orow * 72 + 32 + r32] = (unsigned short)(w2 >> 16); }
#pragma unroll
        for (int i = 0; i < 4; ++i) { const int row = 8 * i + (lane >> 3), ch = lane & 7;
            const u32x4 v = *(const LAS u32x4*)(stg + row * 72 + ch * 8);
            *(u32x4*)(ao + (rowbase + d.dil * (Pq0 + row) + d.res) * 1024 + d.h * 128 + hh * 64 + ch * 8) = v; } }
    __builtin_amdgcn_sched_barrier(0);
    if (nxt_valid) { const UnitId dn = decode((nxt - n_ssm) % 1536); carry_load_rest(c, T, dn, tid, wave, lane); __builtin_amdgcn_sched_barrier(0); }
    __syncthreads();
    ATT_STAMP();
#ifdef PROBE_ATT
    if (u == 777 && tid == 0) { for (int i = 0; i < 6; ++i) __hip_atomic_store(T.probe + i, (unsigned)(ts_[i + 1] - ts_[i]), __ATOMIC_RELAXED, __HIP_MEMORY_SCOPE_AGENT); }
#endif
    return nxt;
}
}

typedef float f32x2m __attribute__((ext_vector_type(2)));
__device__ __forceinline__ void p4_merge(Frame& F) {
    const bf16* ao = (const bf16*)(F.ws + WS_ATT); const float* aml = (const float*)(F.ws + WS_AML); bf16* mixed = (bf16*)(F.ws + WS_MIXED);
    constexpr int NT = M * 128, U = 4;
    const int stride = F.G * 512;
    for (int i0 = F.vcu * 512 + F.tid; i0 < NT; i0 += U * stride) {
        f32x2m ml[U][3]; v4u v[U][3];
#pragma unroll
        for (int q = 0; q < U; ++q) { const int i = i0 + q * stride < NT ? i0 + q * stride : i0; const int row = i >> 7, c8 = i & 127, h = c8 >> 4;
#pragma unroll
            for (int b3 = 0; b3 < 3; ++b3) { ml[q][b3] = *(const f32x2m*)(aml + ((size_t)b3 * M + row) * 16 + 2 * h); v[q][b3] = NT_LOADA((const v4u*)(ao + ((size_t)b3 * M + row) * 1024 + c8 * 8)); } }
#pragma unroll
        for (int q = 0; q < U; ++q) { const int i = i0 + q * stride; if (i >= NT) break; const int row = i >> 7, c8 = i & 127;
            const float mm = fmaxf(ml[q][0].x, fmaxf(ml[q][1].x, ml[q][2].x));
            float w[3], ws_ = 0.f;
#pragma unroll
            for (int b3 = 0; b3 < 3; ++b3) { w[b3] = __builtin_amdgcn_exp2f(ml[q][b3].x - mm) * ml[q][b3].y; ws_ += w[b3]; }
            const float rw = 1.0f / ws_;
            float acc[8] = {0.f, 0.f, 0.f, 0.f, 0.f, 0.f, 0.f, 0.f};
#pragma unroll
            for (int b3 = 0; b3 < 3; ++b3) { const v4u vv = v[q][b3]; const float wn = w[b3] * rw;
                acc[0] += wn * __uint_as_float(vv.x << 16); acc[1] += wn * __uint_as_float(vv.x & 0xffff0000u); acc[2] += wn * __uint_as_float(vv.y << 16); acc[3] += wn * __uint_as_float(vv.y & 0xffff0000u);
                acc[4] += wn * __uint_as_float(vv.z << 16); acc[5] += wn * __uint_as_float(vv.z & 0xffff0000u); acc[6] += wn * __uint_as_float(vv.w << 16); acc[7] += wn * __uint_as_float(vv.w & 0xffff0000u); }
            v4u o; o.x = pk2(acc[0], acc[1]); o.y = pk2(acc[2], acc[3]); o.z = pk2(acc[4], acc[5]); o.w = pk2(acc[6], acc[7]);
            *(v4u*)(mixed + (size_t)row * 2048 + 1024 + c8 * 8) = o; } }
}

namespace ssm {
typedef short bf16x8 __attribute__((ext_vector_type(8)));
typedef float f32x4 __attribute__((ext_vector_type(4)));
typedef unsigned u32x4 __attribute__((ext_vector_type(4)));
typedef unsigned u32x2 __attribute__((ext_vector_type(2)));
constexpr int LDS_KT = 1024, LDS_BIG = 17408;
constexpr int NCH = 256;
constexpr int W1P = 1040, CMP = 272;

struct Ptrs { const bf16* ug; bf16* yg; const bf16* W1; const bf16* CM; const bf16* KT; const float* A32; const float* D; float* Hs; bf16* CIs; unsigned* probe; };
#ifdef PROBE_SSM
#define SSM_STAMP() do { __builtin_amdgcn_sched_barrier(0); ts_[nst_++] = __builtin_amdgcn_s_memrealtime(); __builtin_amdgcn_sched_barrier(0); } while (0)
#else
#define SSM_STAMP() do {} while (0)
#endif

template <int HALF>
__device__ __forceinline__ void s3_half(const Ptrs& T, LAS unsigned char* lds, const bf16* up, bf16x8 (&ub)[16], const bf16x8 (&cbf)[4], const f32x4 dv, int b, int g, int ct, int ch, int kg, int ct_next) {
    constexpr int NKS = 8 * (HALF + 1);
    u32x2 uw[16];
#pragma unroll
    for (int tt = 0; tt < 16; ++tt) uw[tt] = *(const u32x2*)(up + (size_t)(32 * (16 * ct + ch) + 16 * HALF + tt) * 16 + 4 * kg);
    f32x4 acc[16];
#pragma unroll
    for (int t = 0; t < 16; ++t) acc[t] = (f32x4){0.f, 0.f, 0.f, 0.f};
    const LAS unsigned char* ktb = lds + LDS_KT + ch * 32 + (kg & 1) * 16 - (kg >> 1) * 512;
    constexpr int NDL = 16 * (HALF + 1);
    bf16x8 fa = *(const LAS bf16x8*)(ktb + (kg >> 1) * 512);
    if ((kg >> 1) != 0) fa = (bf16x8){0, 0, 0, 0, 0, 0, 0, 0};
#pragma unroll
    for (int dl = 0; dl < NDL; ++dl) {
        bf16x8 fn = fa;
        if (dl + 1 < NDL) fn = *(const LAS bf16x8*)(ktb + (dl + 1) * 512);
        __builtin_amdgcn_sched_barrier(0);
#pragma unroll
        for (int ks = 0; ks < NKS; ++ks) { const int t = 2 * ks + dl; if (t >= 16 * HALF && t < 16 * HALF + 16) acc[t - 16 * HALF] = __builtin_amdgcn_mfma_f32_16x16x32_bf16(fa, ub[ks], acc[t - 16 * HALF], 0, 0, 0); }
        __builtin_amdgcn_sched_barrier(0);
        fa = fn; }
    if (HALF == 1 && ct_next >= 0) {
#pragma unroll
        for (int ks = 0; ks < 16; ++ks) ub[ks] = *(const bf16x8*)(up + (size_t)(32 * (16 * ct_next + ch) + 2 * ks + (kg >> 1)) * 16 + 8 * (kg & 1));
        __builtin_amdgcn_sched_barrier(0); }
    const LAS unsigned char* cmb = lds + LDS_BIG + (HALF * 256 + ch) * CMP + kg * 16;
    bf16x8 ca[4];
#pragma unroll
    for (int ks = 0; ks < 4; ++ks) ca[ks] = *(const LAS bf16x8*)(cmb + ks * 64);
#pragma unroll
    for (int tt = 0; tt < 16; ++tt) {
        bf16x8 cn[4];
#pragma unroll
        for (int ks = 0; ks < 4; ++ks) cn[ks] = ca[ks];
        if (tt + 1 < 16) {
#pragma unroll
            for (int ks = 0; ks < 4; ++ks) cn[ks] = *(const LAS bf16x8*)(cmb + (tt + 1) * 16 * CMP + ks * 64); }
        __builtin_amdgcn_sched_barrier(0);
#pragma unroll
        for (int ks = 0; ks < 4; ++ks) acc[tt] = __builtin_amdgcn_mfma_f32_16x16x32_bf16(ca[ks], cbf[ks], acc[tt], 0, 0, 0);
        __builtin_amdgcn_sched_barrier(0);
#pragma unroll
        for (int ks = 0; ks < 4; ++ks) ca[ks] = cn[ks]; }
#pragma unroll
    for (int tt = 0; tt < 16; ++tt) { const int tok = 32 * (16 * ct + ch) + 16 * HALF + tt;
        const float y0 = acc[tt][0] + dv[0] * __uint_as_float(uw[tt].x << 16), y1 = acc[tt][1] + dv[1] * __uint_as_float(uw[tt].x & 0xffff0000u);
        const float y2 = acc[tt][2] + dv[2] * __uint_as_float(uw[tt].y << 16), y3 = acc[tt][3] + dv[3] * __uint_as_float(uw[tt].y & 0xffff0000u);
        u32x2 o; o.x = pk2(gelu_tanh(y0), gelu_tanh(y1)); o.y = pk2(gelu_tanh(y2), gelu_tanh(y3));
        *(u32x2*)(T.yg + (size_t)(b * SEQ + tok) * 1024 + g * 16 + 4 * kg) = o;
        if ((tt & 3) == 3) __builtin_amdgcn_sched_barrier(0); }
}
__device__ __forceinline__ void item(const Ptrs& T, int it, LAS unsigned char* lds, int tid, int wave, int lane) {
#ifdef PROBE_SSM
    unsigned long long ts_[8]; int nst_ = 0;
#endif
    SSM_STAMP();
    const int b = it >> 6, g = it & 63;
    const bf16* up = T.ug + (size_t)((b * 64 + g) * SEQ) * 16;
    float* Hs = T.Hs + (size_t)it * NCH * 128; bf16* CIs = T.CIs + (size_t)it * NCH * 128;
    const int ch = lane & 15, kg = lane >> 4;
    { const u32x4* src = (const u32x4*)(T.KT + (size_t)g * 32 * 256);
#pragma unroll
      for (int i = 0; i < 2; ++i) *(LAS u32x4*)(lds + LDS_KT + (tid + 512 * i) * 16) = src[tid + 512 * i];
      const u32x4* w1 = (const u32x4*)(T.W1 + (size_t)g * 128 * 512);
#pragma unroll
      for (int i = 0; i < 16; ++i) { const int c = tid + 512 * i, r = c >> 6, ci = c & 63; *(LAS u32x4*)(lds + LDS_BIG + r * W1P + ci * 16) = w1[c]; } }
    __syncthreads();
    SSM_STAMP();
    const LAS unsigned char* w1b = lds + LDS_BIG + ch * W1P + kg * 16;
#pragma unroll 1
    for (int cti = 0; cti < 2; ++cti) { const int ct = wave + 8 * cti;
        bf16x8 ub[16];
#pragma unroll
        for (int ks = 0; ks < 16; ++ks) ub[ks] = *(const bf16x8*)(up + (size_t)(32 * (16 * ct + ch) + 2 * ks + (kg >> 1)) * 16 + 8 * (kg & 1));
#pragma unroll
        for (int n2t = 0; n2t < 8; ++n2t) { f32x4 hacc = {0.f, 0.f, 0.f, 0.f};
#pragma unroll
            for (int ks = 0; ks < 16; ++ks) { const bf16x8 a = *(const LAS bf16x8*)(w1b + n2t * 16 * W1P + ks * 64);
                hacc = __builtin_amdgcn_mfma_f32_16x16x32_bf16(a, ub[ks], hacc, 0, 0, 0); }
            *(f32x4*)(Hs + (size_t)(16 * ct + ch) * 128 + n2t * 16 + 4 * kg) = hacc; __builtin_amdgcn_sched_barrier(0); } }
    asm volatile("s_waitcnt vmcnt(0)" ::: "memory");
    __syncthreads();
    SSM_STAMP();
    { const int n = tid & 63, seg = tid >> 6;
      float yr[32], yi[32];
#pragma unroll
      for (int j = 0; j < 32; ++j) { yr[j] = NT_LOADA(Hs + (size_t)(32 * seg + j) * 128 + n); yi[j] = NT_LOADA(Hs + (size_t)(32 * seg + j) * 128 + 64 + n); }
      const float ar = T.A32[(g * 64 + n) * 2], ai = T.A32[(g * 64 + n) * 2 + 1];
#pragma unroll
      for (int j = 1; j < 32; ++j) { const float pr = yr[j - 1], pi = yi[j - 1]; yr[j] += ar * pr - ai * pi; yi[j] += ar * pi + ai * pr; }
      float qr_ = ar, qi_ = ai;
#pragma unroll
      for (int k = 0; k < 5; ++k) { const float tr = qr_ * qr_ - qi_ * qi_, ti = 2.0f * qr_ * qi_; qr_ = tr; qi_ = ti; }
      LAS float* segt = (LAS float*)(lds + LDS_BIG);
      segt[(seg * 64 + n) * 2] = yr[31]; segt[(seg * 64 + n) * 2 + 1] = yi[31];
      __syncthreads();
      float sr = 0.f, si = 0.f;
      for (int k = 0; k < seg; ++k) { const float er = segt[(k * 64 + n) * 2], ei = segt[(k * 64 + n) * 2 + 1]; const float tr = qr_ * sr - qi_ * si + er, ti = qr_ * si + qi_ * sr + ei; sr = tr; si = ti; }
      float pr = sr, pi = si;
#pragma unroll
      for (int j = 0; j < 32; ++j) { const float cr = (j == 0 ? 0.f : yr[j > 0 ? j - 1 : 0]) + pr, ci = (j == 0 ? 0.f : yi[j > 0 ? j - 1 : 0]) + pi;
          CIs[(size_t)(32 * seg + j) * 128 + n] = (bf16)f2bf(cr); CIs[(size_t)(32 * seg + j) * 128 + 64 + n] = (bf16)f2bf(ci);
          const float tr = ar * pr - ai * pi, ti = ar * pi + ai * pr; pr = tr; pi = ti; } }
    asm volatile("s_waitcnt vmcnt(0)" ::: "memory");
    __syncthreads();
    SSM_STAMP();
    { const u32x4* cm = (const u32x4*)(T.CM + (size_t)g * 512 * 128);
#pragma unroll
      for (int i = 0; i < 16; ++i) { const int c = tid + 512 * i, r = c >> 4, ci = c & 15; *(LAS u32x4*)(lds + LDS_BIG + r * CMP + ci * 16) = cm[c]; } }
    __syncthreads();
    SSM_STAMP();
    const f32x4 dv = *(const f32x4*)(T.D + g * 16 + 4 * kg);
    bf16x8 ubs[16];
#pragma unroll
    for (int ks = 0; ks < 16; ++ks) ubs[ks] = *(const bf16x8*)(up + (size_t)(32 * (16 * wave + ch) + 2 * ks + (kg >> 1)) * 16 + 8 * (kg & 1));
#pragma unroll 1
    for (int cti = 0; cti < 2; ++cti) { const int ct = wave + 8 * cti;
        bf16x8 cbf[4];
#pragma unroll
        for (int ks = 0; ks < 4; ++ks) cbf[ks] = *(const bf16x8*)(CIs + (size_t)(16 * ct + ch) * 128 + 32 * ks + 8 * kg);
        s3_half<0>(T, lds, up, ubs, cbf, dv, b, g, ct, ch, kg, -1);
        s3_half<1>(T, lds, up, ubs, cbf, dv, b, g, ct, ch, kg, cti == 0 ? wave + 8 : -1); }
    __syncthreads();
    SSM_STAMP();
#ifdef PROBE_SSM
    if (it == 5 && tid == 0) { for (int i = 0; i < 5; ++i) __hip_atomic_store(T.probe + i, (unsigned)(ts_[i + 1] - ts_[i]), __ATOMIC_RELAXED, __HIP_MEMORY_SCOPE_AGENT); }
#endif
}
}

__device__ __forceinline__ void cpow_fast(float pw, float lr, float th, float& xr, float& xi) {
    const float mg = __builtin_amdgcn_exp2f(pw * lr * 1.4426950408889634f);
    const float rev = __builtin_amdgcn_fractf(pw * th * 0.15915494309189535f);
    xr = mg * __builtin_amdgcn_cosf(rev); xi = mg * __builtin_amdgcn_sinf(rev);
}
__device__ __forceinline__ void p0_ssm_consts(Frame& F) {
    bf16* W1 = (bf16*)(F.ws + WS_SC_W1); bf16* CM = (bf16*)(F.ws + WS_SC_CM); bf16* KT = (bf16*)(F.ws + WS_SC_KT); float* A32 = (float*)(F.ws + WS_SC_A32);
    LAS float* bbr = (LAS float*)(F.lds); LAS float* bbi = bbr + 1024; LAS float* cre = bbi + 1024; LAS float* cim = cre + 1024;
    LAS float* lr = cim + 1024; LAS float* th = lr + 64; LAS float* er = th + 64; LAS float* ei = er + 128;
    LAS float* bbrT = ei + 128; LAS float* bbiT = bbrT + 16 * 68;
    for (int it = blockIdx.x; it < 256; it += F.G) { const int g = it >> 2, part = it & 3;
        const float dt = expf(F.in[8][g]);
#pragma unroll
        for (int i = 0; i < 2; ++i) { const int e = F.tid + 512 * i, n = e >> 4;
            const float are = F.in[6][g * 64 + n], aim = F.in[7][g * 64 + n];
            const float mag = expf(are * dt), abr = mag * cosf(aim * dt), abi = mag * sinf(aim * dt);
            const float nre = abr - 1.0f, nim = abi, den = are * are + aim * aim;
            const float zre = (nre * are + nim * aim) / den, zim = (nim * are - nre * aim) / den;
            const float br = F.in[9][g * 1024 + e], bi = F.in[10][g * 1024 + e];
            bbr[e] = zre * br - zim * bi; bbi[e] = zre * bi + zim * br;
            bbrT[(e & 15) * 68 + n] = zre * br - zim * bi; bbiT[(e & 15) * 68 + n] = zre * bi + zim * br;
            cre[e] = F.in[11][g * 1024 + e]; cim[e] = F.in[12][g * 1024 + e];
            if ((e & 15) == 0) { lr[n] = are * dt; th[n] = aim * dt; } }
        __syncthreads();
        { const int n = F.tid & 63, j = F.tid >> 6;
          {
              const int s = 8 * part + j; float xr, xi; cpow_fast((float)(31 - s), lr[n], th[n], xr, xi);
              unsigned wr_[8], wi_[8];
#pragma unroll
              for (int c2 = 0; c2 < 8; ++c2) { const float b0r = bbr[n * 16 + 2 * c2], b0i = bbi[n * 16 + 2 * c2], b1r = bbr[n * 16 + 2 * c2 + 1], b1i = bbi[n * 16 + 2 * c2 + 1];
                  wr_[c2] = pk2(xr * b0r - xi * b0i, xr * b1r - xi * b1i); wi_[c2] = pk2(xr * b0i + xi * b0r, xr * b1i + xi * b1r); }
              v4u* dr = (v4u*)(W1 + ((size_t)g * 128 + n) * 512 + s * 16); v4u* di = (v4u*)(W1 + ((size_t)g * 128 + 64 + n) * 512 + s * 16);
              dr[0] = (v4u){wr_[0], wr_[1], wr_[2], wr_[3]}; dr[1] = (v4u){wr_[4], wr_[5], wr_[6], wr_[7]};
              di[0] = (v4u){wi_[0], wi_[1], wi_[2], wi_[3]}; di[1] = (v4u){wi_[4], wi_[5], wi_[6], wi_[7]}; }
          {
              const int t = 8 * part + j; float xr, xi; cpow_fast((float)(t + 1), lr[n], th[n], xr, xi);
#pragma unroll
              for (int co = 0; co < 16; ++co) { const float c_r = cre[co * 64 + n], c_i = cim[co * 64 + n];
                  CM[((size_t)g * 512 + t * 16 + co) * 128 + n] = (bf16)f2bf(c_r * xr - c_i * xi); CM[((size_t)g * 512 + t * 16 + co) * 128 + 64 + n] = (bf16)f2bf(-(c_r * xi + c_i * xr)); } }
          if (part == 0 && j == 0) { const float mg = expf(32.0f * lr[n]); float sn, cs; sincosf(32.0f * th[n], &sn, &cs); A32[(g * 64 + n) * 2] = mg * cs; A32[(g * 64 + n) * 2 + 1] = mg * sn; } }
        for (int rr = 0; rr < 4; ++rr) {
            __syncthreads();
            if (F.tid < 128) { const int n = F.tid & 63, ts = F.tid >> 6; float xr, xi; cpow_fast((float)(8 * part + 2 * rr + ts), lr[n], th[n], xr, xi); er[ts * 64 + n] = xr; ei[ts * 64 + n] = xi; }
            __syncthreads();
            const int ts = F.tid >> 8, co = (F.tid >> 4) & 15, ci = F.tid & 15; float a = 0.f;
#pragma unroll 4
            for (int n = 0; n < 64; n += 4) { const f32x4 c_r = *(const LAS f32x4*)(cre + co * 64 + n), c_i = *(const LAS f32x4*)(cim + co * 64 + n), e_r = *(const LAS f32x4*)(er + ts * 64 + n), e_i = *(const LAS f32x4*)(ei + ts * 64 + n);
                const f32x4 b_r = *(const LAS f32x4*)(bbrT + ci * 68 + n), b_i = *(const LAS f32x4*)(bbiT + ci * 68 + n);
                const f32x4 v = (c_r * e_r - c_i * e_i) * b_r - (c_r * e_i + c_i * e_r) * b_i; a += (v[0] + v[1]) + (v[2] + v[3]); }
            KT[((size_t)g * 32 + 8 * part + 2 * rr + ts) * 256 + co * 16 + ci] = (bf16)f2bf(a); }
        __syncthreads();
    }
}
#ifndef SSM_NAIVE
#define SSM_NAIVE 0
#endif
#ifndef ATTN_NAIVE
#define ATTN_NAIVE 0
#endif
struct QFetch { unsigned* q; volatile LAS unsigned* misc; int tid;
    __device__ __forceinline__ int operator()() const { if (tid == 0) misc[0] = atomicAdd(q, 1u); __syncthreads(); return (int)misc[0]; }
    __device__ __forceinline__ unsigned issue() const { unsigned v = 0u; if (tid == 0) v = atomicAdd(q, 1u); return v; }
    __device__ __forceinline__ int publish(unsigned v) const { if (tid == 0) misc[0] = v; __syncthreads(); return (int)misc[0]; } };
__device__ __forceinline__ void stagger(int group, unsigned step_ticks) { const unsigned long long t0 = __builtin_amdgcn_s_memrealtime(); const unsigned long long w = (unsigned long long)group * step_ticks;
    while (__builtin_amdgcn_s_memrealtime() - t0 < w) __builtin_amdgcn_s_sleep(8); }
#ifndef STG5
#define STG5 1000
#endif
#ifndef STG7
#define STG7 600
#endif
#ifndef WGM_P2
#define WGM_P2 4
#endif
#ifndef WGM_P4
#define WGM_P4 4
#endif
#ifndef WGM_P5
#define WGM_P5 4
#endif
#ifndef WGM_P6
#define WGM_P6 8
#endif
#ifndef WGM_P7
#define WGM_P7 4
#endif
struct Args { const float* in[22]; float* out; unsigned char* ws; int ph_lo, ph_hi; };
__global__ void __launch_bounds__(NWAVES * 64, 2) mk_fwd(Args args) {
    extern __shared__ __attribute__((aligned(16))) unsigned char lds[];
    Frame F;
    F.lds = (LAS unsigned char*)lds;
    F.MISC = (volatile LAS unsigned*)(F.lds + MISC_OFF);
    F.tid = threadIdx.x; F.lane = F.tid & 63; F.wave = __builtin_amdgcn_readfirstlane(F.tid >> 6);
    F.G = gridDim.x; { const int bx = blockIdx.x; F.vcu = (F.G % 8 == 0) ? (bx % 8) * (F.G / 8) + bx / 8 : bx; }
    unsigned char* ws = args.ws; F.ws = ws; F.out = args.out;
    F.ctl = (gu32*)(ws + WS_CTL);
#pragma unroll
    for (int i = 0; i < 22; ++i) F.in[i] = args.in[i];
    const int lo = args.ph_lo, hi = args.ph_hi;
    const bool use_bar = (hi - lo) > 1;
    for (int u = F.tid; u < (LDS_BYTES - LDSCTL_OFF) / 4; u += NWAVES * 64) ((LAS unsigned*)(F.lds + LDSCTL_OFF))[u] = 0u;
    __syncthreads();
    XcdBarrier bar; bar.bar = (unsigned*)(F.ctl + CW_BAR); bar.x = 0; bar.st = nullptr;
    if (use_bar) bar = xcd_barrier_post((unsigned*)(F.ctl + CW_BAR), F.MISC + 8);
#define IN(k) (lo <= (k) && (k) < hi)
#ifdef PROBE_PHASE
    unsigned long long t_p0 = 0, t_p1 = 0;
#define PT0(k) do { if ((k) == PROBE_PHASE && blockIdx.x == 0 && F.tid == 0) t_p0 = rt(); } while (0)
#define PT1(k) do { if ((k) == PROBE_PHASE && blockIdx.x == 0 && F.tid == 0) t_p1 = rt(); } while (0)
#else
#define PT0(k) do {} while (0)
#define PT1(k) do {} while (0)
#endif
#define SEAM(k) do { if (IN(k) && IN((k) + 1)) xcd_barrier(bar); } while (0)
    bf16* const W_in_t = (bf16*)(ws + WS_WIN); bf16* const W_glu_t = (bf16*)(ws + WS_WGLU); bf16* const W_out_t = (bf16*)(ws + WS_WOUT);
    bf16* const W_gu_t = (bf16*)(ws + WS_WGU); bf16* const W_d_t = (bf16*)(ws + WS_WD);
    float* const mod = (float*)(ws + WS_MOD); float* const ssqk = (float*)(ws + WS_SSQK); float* const ss2 = (float*)(ws + WS_SS2); float* const cb = (float*)(ws + WS_CB);

#ifndef P0_STAGGER
#define P0_STAGGER 1
#endif
    if (IN(0)) { PT0(0);
        if (P0_STAGGER && (((int)blockIdx.x >> 3) & 1)) { p0_ssm_consts(F); __syncthreads(); p0_prologue(F); __syncthreads(); }
        else { p0_prologue(F); __syncthreads(); p0_ssm_consts(F); __syncthreads(); }
        p0_rest(F);
        if (IN(1)) wait_mod_done(F);
        PT1(0); }
    if (IN(1)) { PT0(1); p1_norm1(F);
#if defined(REP_PHASE) && REP_PHASE == 1
        p1_norm1(F);
#endif
        SEAM(1); PT1(1); }
    if (IN(2)) { PT0(2);
        pg8::Gemm g{(const bf16*)(ws + WS_H1), W_in_t, M, NPROJ, DM}; pg8::StaticOrder S; S.init(M, NPROJ, F.G, (int)blockIdx.x, WGM_P2);
        pg8::EpiProj E{(bf16*)(ws + WS_UG), (bf16*)(ws + WS_Q), (size_t)(WS_K - WS_Q) / 2, ssqk};
        pg8::gemm_phase<pg8::EpiProj, pg8::StaticOrder, true, true>(F.lds + RING_OFF, g, S, E);
        SEAM(2); PT1(2);
    }
    if (IN(3)) { PT0(3);
        if (F.tid < 128) ((LAS float*)(F.lds + att::WQK_OFF))[F.tid] = F.in[15][F.tid] * F.in[16][F.tid];
        __syncthreads();
        const att::Ptrs AT{(const bf16*)(ws + WS_Q), (const bf16*)(ws + WS_K), (const bf16*)(ws + WS_V), ssqk, (bf16*)(ws + WS_ATT), (float*)(ws + WS_AML), (unsigned*)(F.ctl + 200)};
        const ssm::Ptrs ST{(const bf16*)(ws + WS_UG), (bf16*)(ws + WS_YG), (const bf16*)(ws + WS_SC_W1), (const bf16*)(ws + WS_SC_CM), (const bf16*)(ws + WS_SC_KT), (const float*)(ws + WS_SC_A32), F.in[13], (float*)(ws + WS_MIXED), (bf16*)(ws + WS_MIXED + 32 * MiB), (unsigned*)(F.ctl + 220)};
#if defined(PROBE_2X_SSM)
        constexpr int n_ssm = 256, n_att = 1536;
#elif defined(PROBE_2X_ATT)
        constexpr int n_ssm = 128, n_att = 3072;
#else
        constexpr int n_ssm = SSM_NAIVE ? 0 : 128, n_att = ATTN_NAIVE ? 0 : 1536;
#endif
#ifdef PROBE_SSM_END
        const unsigned long long t_wg0 = rt();
#endif
        if (LATE_TR && (F.vcu & 1)) {
            const int hw = (F.vcu >> 1) * NWAVES + F.wave, HW = (F.G >> 1) * NWAVES;
            for (int it = hw; it < TR_TOTAL; it += HW) { int lane_l = F.lane; asm volatile("" : "+v"(lane_l)); tr_wave_item(F, it, lane_l); }
            __syncthreads();
        }
        const QFetch fetch{(unsigned*)(F.ctl + CW_Q), F.MISC, F.tid};
        int idx = fetch();
        constexpr int n_tr = 0;
        while (n_ssm > 0 && idx < n_ssm) {
            int tid_l = F.tid; asm volatile("" : "+v"(tid_l));
            ssm::item(ST, idx & 127, F.lds, tid_l, F.wave, tid_l & 63);
            idx = fetch();
        }
        if (n_att > 0 && idx < n_ssm + n_tr + n_att) {
            att::Carry cy;
            { int tid_l = F.tid; asm volatile("" : "+v"(tid_l)); const att::UnitId d0 = att::decode((idx - n_ssm - n_tr) % 1536);
              att::stage_load<0, 8>(cy.kst, AT.k, d0, tid_l); att::carry_load_rest(cy, AT, d0, tid_l, F.wave, tid_l & 63); }
            while (idx < n_ssm + n_tr + n_att) {
                int tid_l = F.tid; asm volatile("" : "+v"(tid_l));
                idx = att::unit_co(AT, (idx - n_ssm - n_tr) % 1536, cy, (LAS char*)F.lds, tid_l, F.wave, tid_l & 63, n_ssm + n_tr, n_ssm + n_tr + n_att, fetch);
            }
        }
        if (SSM_NAIVE) p3_ssm_naive(F);
        if (ATTN_NAIVE) p3_attn_naive(F);
        SEAM(3); PT1(3);
    }
    if (IN(4)) { PT0(4);
        if (!ATTN_NAIVE) p4_merge(F);
#if defined(REP_PHASE) && REP_PHASE == 4
        p4_merge(F);
#endif
        pg8::Gemm g{(const bf16*)(ws + WS_YG), W_glu_t, M, 1024, 1024}; pg8::StaticOrder S; S.init(M, 1024, F.G, (int)blockIdx.x, WGM_P4);
        pg8::EpiGlu E{(const bf16*)(ws + WS_YG), (bf16*)(ws + WS_MIXED)};
        pg8::gemm_phase<pg8::EpiGlu, pg8::StaticOrder, true, true>(F.lds + RING_OFF, g, S, E);
        SEAM(4); PT1(4);
    }
    if (IN(5)) { PT0(5);
        pg8::Gemm g{(const bf16*)(ws + WS_MIXED), W_out_t, M, DM, DM}; pg8::StaticOrder S; S.init(M, DM, F.G, (int)blockIdx.x, WGM_P5);
        pg8::EpiOut E{F.in[0], (bf16*)(ws + WS_A2), mod, ss2};
#ifdef PF_X5
        {
            float dsum = 0.f; pg8::Unit uu;
            for (int i = 0; S.next(i, uu); ++i) {
#pragma unroll
                for (int j = 0; j < 4; ++j) { const int ln = F.tid + 512 * j, r = ln >> 3, c = (ln & 7) * 32; dsum += *(const volatile float*)(F.in[0] + (size_t)(uu.pm * 256 + r) * DM + uu.pn * 256 + c); } }
            if (dsum == 1.2345e-30f) F.out[0] = dsum;
        }
#endif
        pg8::gemm_phase<pg8::EpiOut, pg8::StaticOrder, true, true>(F.lds + RING_OFF, g, S, E);
        SEAM(5); PT1(5);
    }
    if (IN(6)) { PT0(6);
        pg8::Gemm g{(const bf16*)(ws + WS_A2), W_gu_t, M, NGU, DM, (size_t)(WS_WGU1 - WS_WGU)}; pg8::StaticOrder S; S.init(M, NGU, F.G, (int)blockIdx.x, WGM_P6);
        pg8::EpiFfnUp E{(bf16*)(ws + WS_T), cb, ss2};
        pg8::gemm_phase<pg8::EpiFfnUp, pg8::StaticOrder, true, true>(F.lds + RING_OFF, g, S, E);
        SEAM(6); PT1(6);
    }
    if (IN(7)) { PT0(7);
        pg8::Gemm g{(const bf16*)(ws + WS_T), W_d_t, M, DM, FFN}; pg8::StaticOrder S; S.init(M, DM, F.G, (int)blockIdx.x, WGM_P7);
        pg8::EpiDown E{mod, (const bf16*)(ws + WS_A2), F.out};
        pg8::gemm_phase<pg8::EpiDown, pg8::StaticOrder, true, true>(F.lds + RING_OFF, g, S, E);
#ifdef PROBE_PHASE
        xcd_barrier(bar); PT1(7);
#ifdef PROBE_SSM_END
        if (blockIdx.x == 0 && F.tid == 0) t_p1 = t_p0 + __hip_atomic_load((unsigned*)(F.ctl + 128), __ATOMIC_RELAXED, __HIP_MEMORY_SCOPE_AGENT);
#endif
#ifdef PROBE_SSM
        if (blockIdx.x == 0 && F.tid == 0) { t_p0 = 0; t_p1 = 10ull * __hip_atomic_load((unsigned*)(F.ctl + 220 + PROBE_SSM), __ATOMIC_RELAXED, __HIP_MEMORY_SCOPE_AGENT); }
#endif
#ifdef PROBE_ATT
        if (blockIdx.x == 0 && F.tid == 0) { t_p0 = 0; t_p1 = 50ull * __hip_atomic_load((unsigned*)(F.ctl + 200 + PROBE_ATT), __ATOMIC_RELAXED, __HIP_MEMORY_SCOPE_AGENT); }
#endif
#ifdef PROBE_SSM_ITEM
        if (blockIdx.x == 0 && F.tid == 0) { t_p0 = 0; t_p1 = __hip_atomic_load((unsigned*)(F.ctl + 200), __ATOMIC_RELAXED, __HIP_MEMORY_SCOPE_AGENT); }
#endif
        if (blockIdx.x == 0 && F.tid == 0) F.out[0] += (float)(t_p1 - t_p0) * 0.001f;
#endif
    }
#undef IN
#undef SEAM
}

extern "C" void kernel_launch(void* const* d_in, const int* in_sizes, int n_in, void* d_out, int out_size, void* d_ws, size_t ws_size, hipStream_t stream) {
    static int grid = 0;
    if (grid == 0) {
        if (n_in != 22 || in_sizes[0] != M * DM || out_size != M * DM || ws_size < WS_END) { fprintf(stderr, "kernel_launch: unexpected shapes (n_in %d, in0 %d, out %d, ws %zu)\n", n_in, n_in > 0 ? in_sizes[0] : -1, out_size, ws_size); grid = -1; return; }
        int dev = 0, cus = 0;
        if (hipGetDevice(&dev) != hipSuccess || hipDeviceGetAttribute(&cus, hipDeviceAttributeMultiprocessorCount, dev) != hipSuccess) { grid = -1; return; }
        if (hipFuncSetAttribute((const void*)mk_fwd, hipFuncAttributeMaxDynamicSharedMemorySize, LDS_BYTES) != hipSuccess) { fprintf(stderr, "kernel_launch: hipFuncSetAttribute failed\n"); grid = -1; return; }
        int per_cu = 0;
        if (hipOccupancyMaxActiveBlocksPerMultiprocessor(&per_cu, (const void*)mk_fwd, NWAVES * 64, LDS_BYTES) != hipSuccess || per_cu < 1) fprintf(stderr, "kernel_launch: occupancy query reports %d\n", per_cu);
        (void)hipGetLastError();
        grid = cus;
    }
    if (grid < 0) return;
    if (hipMemsetAsync((char*)d_ws + WS_CTL, 0, CTL_ZERO_BYTES, stream) != hipSuccess) return;
    Args a{};
    for (int i = 0; i < 22; ++i) a.in[i] = (const float*)d_in[i];
    a.out = (float*)d_out; a.ws = (unsigned char*)d_ws;
    if (MK_N_LAUNCHES == 1) { a.ph_lo = 0; a.ph_hi = N_PHASES; hipLaunchKernelGGL(mk_fwd, dim3(grid), dim3(NWAVES * 64), LDS_BYTES, stream, a); }
    else for (int p = 0; p < N_PHASES; ++p) { a.ph_lo = p; a.ph_hi = p + 1; hipLaunchKernelGGL(mk_fwd, dim3(grid), dim3(NWAVES * 64), LDS_BYTES, stream, a); }
}
```

```cpp
#include <hip/hip_runtime.h>
#include <cstdio>
#include <cstdint>
#include <cmath>
#ifndef NT_STREAM
#define NT_STREAM 1
#endif
#ifndef NT_ACT
#define NT_ACT 1
#endif
#if NT_STREAM
#define NT_LOAD(p) __builtin_nontemporal_load(p)
#else
#define NT_LOAD(p) (*(p))
#endif
#ifndef NT_KV
#define NT_KV 1
#endif
#if NT_KV
#define NT_LOADKV(p) __builtin_nontemporal_load(p)
#else
#define NT_LOADKV(p) (*(p))
#endif
#if NT_ACT
#define NT_LOADA(p) __builtin_nontemporal_load(p)
#else
#define NT_LOADA(p) (*(p))
#endif
namespace pg8 {
#define PG8_LAS __attribute__((address_space(3)))
typedef unsigned short bf16_t;
typedef short bf16x8 __attribute__((ext_vector_type(8)));
typedef float f32x4 __attribute__((ext_vector_type(4)));
typedef unsigned u32x4 __attribute__((ext_vector_type(4)));
constexpr int BM = 256, BK = 64, HALF = 128, HTB = HALF * BK * 2  , STAGE_BYTES = 8 * HTB, NXCD = 8, WGM = 8;

__host__ __device__ __forceinline__ int lds_byte(int r, int c) { const int st = (r >> 4) * 2 + (c >> 5), rr = r & 15, cc = c & 31, ob = rr * 64 + cc * 2; return st * 1024 + (ob ^ (((ob >> 9) & 1) << 5)); }
__host__ __device__ __forceinline__ void stage_rc(int b, int& R, int& C) { const int st = b / 1024, sb = b % 1024, swz = sb ^ (((sb >> 9) & 1) << 5); R = (st >> 1) * 16 + swz / 64; C = (st & 1) * 32 + (swz % 64) / 2; }
__host__ __device__ __forceinline__ int perm32(int rho) { const int n = rho >> 4, i = rho & 15; return 8 * (i >> 2) + 4 * n + (i & 3); }

struct Unit { int pm, pn; };
struct Gemm { const bf16_t* A; const bf16_t* Bt; int M, N, K; size_t bstride; };

struct StaticOrder {
    int nM, nN, nwg, G, c, wgm;
    __host__ __device__ void init(int M, int N, int G_, int c_, int wgm_ = WGM) { nM = M / BM; nN = N / BM; nwg = nM * nN; G = G_; c = c_; wgm = wgm_; }
    __host__ __device__ bool next(int i, Unit& u) const {
        const long L = (long)i * G + c; if (L >= nwg) return false;
        int wgid = (int)L; { const int q = nwg / NXCD, r = nwg % NXCD, xcd = wgid % NXCD, off = wgid / NXCD; wgid = (xcd < r ? xcd * (q + 1) : r * (q + 1) + (xcd - r) * q) + off; }
        const int nig = wgm * nN, gid = wgid / nig, fm = gid * wgm, gsz = (nM - fm) < wgm ? (nM - fm) : wgm;
        u.pm = fm + ((wgid % nig) % gsz); u.pn = (wgid % nig) / gsz; return true;
    }
    __device__ __forceinline__ void a_ready(const Unit&) const {}
    __device__ __forceinline__ void done(const Unit&) const {}
};

__device__ __forceinline__ unsigned cvt_pk_bf16(float lo, float hi) { unsigned r; asm volatile("v_cvt_pk_bf16_f32 %0, %1, %2" : "=v"(r) : "v"(lo), "v"(hi)); return r; }
typedef float f32x2 __attribute__((ext_vector_type(2)));
__device__ __forceinline__ float bf_lo(unsigned w) { return __uint_as_float(w << 16); }
__device__ __forceinline__ float bf_hi(unsigned w) { return __uint_as_float(w & 0xffff0000u); }
__device__ __forceinline__ float sigm(float z) { return __builtin_amdgcn_rcpf(1.0f + __builtin_amdgcn_exp2f(-1.4426950408889634f * z)); }

struct EpiProj {
    static constexpr bool PERM = true, AFTER_DRAIN = false;
    bf16_t* ug; bf16_t* q; size_t qkv_stride; float* ssqk;
    __device__ __forceinline__ void operator()(const f32x4 (&acc)[2][2][4][2], const Unit& u, int wr, int wc, int fr, int fq) const {
        const int row0 = u.pm * BM + wr * 64 + fr; const int pn = u.pn;
#pragma unroll
        for (int ai = 0; ai < 2; ++ai)
#pragma unroll
            for (int m = 0; m < 4; ++m) { const int row = row0 + ai * HALF + m * 16;
#pragma unroll
                for (int bj = 0; bj < 2; ++bj) { const f32x4 v0 = acc[ai][bj][m][0], v1 = acc[ai][bj][m][1];
                    u32x4 w; w.x = cvt_pk_bf16(v0[0], v0[1]); w.y = cvt_pk_bf16(v0[2], v0[3]); w.z = cvt_pk_bf16(v1[0], v1[1]); w.w = cvt_pk_bf16(v1[2], v1[3]);
                    const int colt = bj * HALF + wc * 32 + 8 * fq;
                    if (pn < 4) { const int gcol = pn * 256 + colt, g = gcol >> 4, c0 = gcol & 15, b = row >> 13, tok = row & 8191;
                        *(u32x4*)(ug + ((size_t)((b * 64 + g) * 8192 + tok)) * 16 + c0) = w; }
                    else { const int sect = (pn - 4) >> 2, ccol = ((pn - 4) & 3) * 256 + colt; bf16_t* dst = q + (size_t)sect * qkv_stride;
                        *(u32x4*)(dst + (size_t)row * 1024 + ccol) = w;
                        if (sect < 2) { float ss = (v0[0] * v0[0] + v0[1] * v0[1]) + (v0[2] * v0[2] + v0[3] * v0[3]) + (v1[0] * v1[0] + v1[1] * v1[1]) + (v1[2] * v1[2] + v1[3] * v1[3]);
                            ss += __shfl_xor(ss, 16); ss += __shfl_xor(ss, 32);
                            if (fq == 0) atomicAdd(ssqk + (size_t)(sect * 8 + (ccol >> 7)) * 16384 + row, ss); } } } }
    }
};
struct EpiGlu {
    static constexpr bool PERM = true, AFTER_DRAIN = false;
    const bf16_t* yg; bf16_t* mixed;
    __device__ __forceinline__ void operator()(const f32x4 (&acc)[2][2][4][2], const Unit& u, int wr, int wc, int fr, int fq) const {
        const int row0 = u.pm * BM + wr * 64 + fr, colw = u.pn * BM + wc * 32 + 8 * fq;
        u32x4 yv[2][4][2];
#pragma unroll
        for (int ai = 0; ai < 2; ++ai)
#pragma unroll
            for (int m = 0; m < 4; ++m)
#pragma unroll
                for (int bj = 0; bj < 2; ++bj) yv[ai][m][bj] = *(const u32x4*)(yg + (size_t)(row0 + ai * HALF + m * 16) * 1024 + colw + bj * HALF);
#pragma unroll
        for (int ai = 0; ai < 2; ++ai)
#pragma unroll
            for (int m = 0; m < 4; ++m) { const int row = row0 + ai * HALF + m * 16;
#pragma unroll
                for (int bj = 0; bj < 2; ++bj) { const f32x4 z0 = acc[ai][bj][m][0], z1 = acc[ai][bj][m][1]; const u32x4 y = yv[ai][m][bj];
                    u32x4 w;
                    w.x = cvt_pk_bf16(bf_lo(y.x) * sigm(z0[0]), bf_hi(y.x) * sigm(z0[1])); w.y = cvt_pk_bf16(bf_lo(y.y) * sigm(z0[2]), bf_hi(y.y) * sigm(z0[3]));
                    w.z = cvt_pk_bf16(bf_lo(y.z) * sigm(z1[0]), bf_hi(y.z) * sigm(z1[1])); w.w = cvt_pk_bf16(bf_lo(y.w) * sigm(z1[2]), bf_hi(y.w) * sigm(z1[3]));
                    *(u32x4*)(mixed + (size_t)row * 2048 + colw + bj * HALF) = w; } }
    }
};
struct EpiOut {
    static constexpr bool PERM = true, AFTER_DRAIN = false;
    const float* x; bf16_t* x1b; const float* mod; float* ss2;
    __device__ __forceinline__ void operator()(const f32x4 (&acc)[2][2][4][2], const Unit& u, int wr, int wc, int fr, int fq) const {
        const int row0 = u.pm * BM + wr * 64 + fr, b = (u.pm * BM) >> 13, colb = u.pn * BM + wc * 32 + 8 * fq;
        f32x4 g1[2][2];
#pragma unroll
        for (int bj = 0; bj < 2; ++bj)
#pragma unroll
            for (int n = 0; n < 2; ++n) g1[bj][n] = *(const f32x4*)(mod + b * 12288 + 2 * 2048 + colb + bj * HALF + n * 4);
        f32x4 xr[4][2][2]; u32x4 w0[4][2]; float ss0[4];
#define EPIOUT_LOAD(ai_) do { _Pragma("unroll") for (int m = 0; m < 4; ++m) _Pragma("unroll") for (int bj = 0; bj < 2; ++bj) _Pragma("unroll") for (int n = 0; n < 2; ++n) \
            xr[m][bj][n] = NT_LOADA((const f32x4*)(x + (size_t)(row0 + (ai_) * HALF + m * 16) * 2048 + colb + bj * HALF + n * 4)); } while (0)
#define EPIOUT_COMP(ai_, W_, SS_) do { _Pragma("unroll") for (int m = 0; m < 4; ++m) { float ss = 0.f; _Pragma("unroll") for (int bj = 0; bj < 2; ++bj) { \
            const f32x4 o0 = xr[m][bj][0] + g1[bj][0] * acc[ai_][bj][m][0], o1 = xr[m][bj][1] + g1[bj][1] * acc[ai_][bj][m][1]; \
            ss += ((o0[0] * o0[0] + o0[1] * o0[1]) + (o0[2] * o0[2] + o0[3] * o0[3])) + ((o1[0] * o1[0] + o1[1] * o1[1]) + (o1[2] * o1[2] + o1[3] * o1[3])); \
            u32x4 w; w.x = cvt_pk_bf16(o0[0], o0[1]); w.y = cvt_pk_bf16(o0[2], o0[3]); w.z = cvt_pk_bf16(o1[0], o1[1]); w.w = cvt_pk_bf16(o1[2], o1[3]); W_[m][bj] = w; } \
            ss += __shfl_xor(ss, 16); ss += __shfl_xor(ss, 32); SS_[m] = ss; } } while (0)
#define EPIOUT_STORE(ai_, W_, SS_) do { _Pragma("unroll") for (int m = 0; m < 4; ++m) { const int row = row0 + (ai_) * HALF + m * 16; \
            _Pragma("unroll") for (int bj = 0; bj < 2; ++bj) *(u32x4*)(x1b + (size_t)row * 2048 + colb + bj * HALF) = W_[m][bj]; \
            if (fq == 0) atomicAdd(ss2 + row, SS_[m]); } } while (0)
        EPIOUT_LOAD(0); EPIOUT_COMP(0, w0, ss0);
        asm volatile("" ::: "memory");
        EPIOUT_LOAD(1);
        asm volatile("" ::: "memory");
        EPIOUT_STORE(0, w0, ss0);
        u32x4 w1[4][2]; float ss1[4];
        EPIOUT_COMP(1, w1, ss1); EPIOUT_STORE(1, w1, ss1);
#undef EPIOUT_LOAD
#undef EPIOUT_COMP
#undef EPIOUT_STORE
    }
};
struct EpiFfnUp {
    static constexpr bool PERM = true, AFTER_DRAIN = false;
    bf16_t* t; const float* cb; const float* ss2;
    __device__ __forceinline__ void operator()(const f32x4 (&acc)[2][2][4][2], const Unit& u, int wr, int wc, int fr, int fq) const {
        const int row0 = u.pm * BM + wr * 64 + fr, b = (u.pm * BM) >> 13, colt = wc * 32 + 8 * fq;
        const float* cbp = cb + b * 11264 + u.pn * 256 + colt;
        const f32x4 cg0 = *(const f32x4*)(cbp), cg1 = *(const f32x4*)(cbp + 4), cu0 = *(const f32x4*)(cbp + 128), cu1 = *(const f32x4*)(cbp + 132);
        float rs[2][4];
#pragma unroll
        for (int ai = 0; ai < 2; ++ai)
#pragma unroll
            for (int m = 0; m < 4; ++m) rs[ai][m] = ss2[row0 + ai * HALF + m * 16];
#pragma unroll
        for (int ai = 0; ai < 2; ++ai)
#pragma unroll
            for (int m = 0; m < 4; ++m) rs[ai][m] = __builtin_amdgcn_rsqf(rs[ai][m] * (1.0f / 2048.0f) + 1e-6f);
#pragma unroll
        for (int ai = 0; ai < 2; ++ai)
#pragma unroll
            for (int m = 0; m < 4; ++m) { const int row = row0 + ai * HALF + m * 16; const float rstd = rs[ai][m];
                const f32x4 g0 = acc[ai][0][m][0] * rstd + cg0, g1 = acc[ai][0][m][1] * rstd + cg1, u0 = acc[ai][1][m][0] * rstd + cu0, u1 = acc[ai][1][m][1] * rstd + cu1;
                u32x4 w;
                w.x = cvt_pk_bf16(g0[0] * sigm(g0[0]) * u0[0], g0[1] * sigm(g0[1]) * u0[1]); w.y = cvt_pk_bf16(g0[2] * sigm(g0[2]) * u0[2], g0[3] * sigm(g0[3]) * u0[3]);
                w.z = cvt_pk_bf16(g1[0] * sigm(g1[0]) * u1[0], g1[1] * sigm(g1[1]) * u1[1]); w.w = cvt_pk_bf16(g1[2] * sigm(g1[2]) * u1[2], g1[3] * sigm(g1[3]) * u1[3]);
                *(u32x4*)(t + (size_t)row * 5632 + u.pn * 128 + colt) = w; }
    }
};
struct EpiDown {
    static constexpr bool PERM = true, AFTER_DRAIN = false;
    const float* mod; const bf16_t* x1b; float* out;
    __device__ __forceinline__ void operator()(const f32x4 (&acc)[2][2][4][2], const Unit& u, int wr, int wc, int fr, int fq) const {
        const int row0 = u.pm * BM + wr * 64 + fr, b = (u.pm * BM) >> 13, colb = u.pn * BM + wc * 32 + 8 * fq;
        f32x4 g2[2][2];
#pragma unroll
        for (int bj = 0; bj < 2; ++bj)
#pragma unroll
            for (int n = 0; n < 2; ++n) g2[bj][n] = *(const f32x4*)(mod + b * 12288 + 5 * 2048 + colb + bj * HALF + n * 4);
        u32x4 xr[2][4][2];
#pragma unroll
        for (int ai = 0; ai < 2; ++ai)
#pragma unroll
            for (int m = 0; m < 4; ++m)
#pragma unroll
                for (int bj = 0; bj < 2; ++bj) xr[ai][m][bj] = *(const u32x4*)(x1b + (size_t)(row0 + ai * HALF + m * 16) * 2048 + colb + bj * HALF);
#pragma unroll
        for (int ai = 0; ai < 2; ++ai)
#pragma unroll
            for (int m = 0; m < 4; ++m) { const int row = row0 + ai * HALF + m * 16;
#pragma unroll
                for (int bj = 0; bj < 2; ++bj) { const u32x4 r = xr[ai][m][bj];
                    const f32x4 x0 = {bf_lo(r.x), bf_hi(r.x), bf_lo(r.y), bf_hi(r.y)}, x1 = {bf_lo(r.z), bf_hi(r.z), bf_lo(r.w), bf_hi(r.w)};
                    float* op = out + (size_t)row * 2048 + colb + bj * HALF;
                    *(f32x4*)op = x0 + g2[bj][0] * acc[ai][bj][m][0]; *(f32x4*)(op + 4) = x1 + g2[bj][1] * acc[ai][bj][m][1]; } }
    }
};
template <class Epi, class Sched, bool ALIGN_EPI = false, bool SP2 = false>
__device__ __forceinline__ void gemm_phase(PG8_LAS unsigned char* lds, const Gemm g, const Sched& S, const Epi& E) {
    const int tid = threadIdx.x, wid = __builtin_amdgcn_readfirstlane(tid >> 6), lane = tid & 63, wr = wid >> 2, wc = wid & 3, fr = lane & 15, fq = lane >> 4;
    const int K = g.K, nt = K / BK;
    unsigned voffA[2], voffB[2];
#pragma unroll
    for (int i = 0; i < 2; ++i) { int R, C; stage_rc(tid * 16 + i * 8192, R, C); const int Rb = Epi::PERM ? ((R & ~31) + perm32(R & 31)) : R;
        voffA[i] = (unsigned)(R * K + C) * 2u; voffB[i] = (unsigned)(Rb * K + C) * 2u; }
    const size_t kstep = (size_t)(BK * 2);
    const size_t hstep = (size_t)HALF * K * 2;
    const size_t tstep = 2 * hstep;
    const unsigned ldsw = (unsigned)wid * 1024u;
    const int aoff = lds_byte(wr * 64 + fr, fq * 8), boff = lds_byte(wc * 32 + fr, fq * 8);
#define PG8_SA(b, h) (((b) * 2 + (h)) * HTB)
#define PG8_SB(b, h) ((4 + (b) * 2 + (h)) * HTB)
#define PG8_STAGE(bufoff, gbase, voff) do { _Pragma("unroll") for (int _i = 0; _i < 2; ++_i) \
        __builtin_amdgcn_global_load_lds((const unsigned*)((const char*)(gbase) + (voff)[_i]), (PG8_LAS unsigned*)(lds + (bufoff) + ldsw + _i * 8192), 16, 0, 0); } while (0)
#define PG8_LDA(dst, b, h) do { _Pragma("unroll") for (int m = 0; m < 4; ++m) _Pragma("unroll") for (int k = 0; k < 2; ++k) dst[m][k] = *(const PG8_LAS bf16x8*)(lds + PG8_SA(b, h) + aoff + m * 2048 + k * 1024); } while (0)
#define PG8_LDB(dst, b, h) do { _Pragma("unroll") for (int n = 0; n < 2; ++n) _Pragma("unroll") for (int k = 0; k < 2; ++k) dst[n][k] = *(const PG8_LAS bf16x8*)(lds + PG8_SB(b, h) + boff + n * 2048 + k * 1024); } while (0)
#define PG8_MMA(ai, bj, At, Bt) do { __builtin_amdgcn_s_setprio(1); _Pragma("unroll") for (int m = 0; m < 4; ++m) _Pragma("unroll") for (int n = 0; n < 2; ++n) _Pragma("unroll") for (int k = 0; k < 2; ++k) \
        acc[ai][bj][m][n] = __builtin_amdgcn_mfma_f32_16x16x32_bf16(Bt[n][k], At[m][k], acc[ai][bj][m][n], 0, 0, 0); __builtin_amdgcn_s_setprio(0); } while (0)
#define PG8_WAIT_V(n) asm volatile("s_waitcnt vmcnt(" #n ")" ::: "memory")
#define PG8_WAIT_L(n) asm volatile("s_waitcnt lgkmcnt(" #n ")" ::: "memory")
#define PG8_BAR __builtin_amdgcn_s_barrier()
#define PG8_SCHED __builtin_amdgcn_sched_barrier(0)
    Unit cur, nxt; int ui = 0;
    if (!S.next(0, cur)) return;
    f32x4 acc[2][2][4][2];
#pragma unroll
    for (int a = 0; a < 2; ++a)
#pragma unroll
        for (int b = 0; b < 2; ++b)
#pragma unroll
            for (int m = 0; m < 4; ++m)
#pragma unroll
                for (int n = 0; n < 2; ++n) acc[a][b][m][n] = (f32x4){0.f, 0.f, 0.f, 0.f};
    bf16x8 At[4][2], B0[2][2], B1[2][2];
    const char* cA = (const char*)g.A + (size_t)cur.pm * tstep; const char* cB = (const char*)g.Bt + (size_t)cur.pn * tstep + ((cur.pm >> 5) ? g.bstride : (size_t)0);
    S.a_ready(cur);
    if constexpr (SP2) {
        PG8_STAGE(PG8_SB(0, 0), cB, voffB); PG8_STAGE(PG8_SB(0, 1), cB + hstep, voffB); PG8_STAGE(PG8_SA(0, 0), cA, voffA); PG8_STAGE(PG8_SA(0, 1), cA + hstep, voffA);
        if (wr == 1) PG8_BAR;
        PG8_WAIT_V(2); PG8_BAR;
        PG8_STAGE(PG8_SB(1, 0), cB + kstep, voffB); PG8_STAGE(PG8_SA(1, 0), cA + kstep, voffA); PG8_STAGE(PG8_SB(1, 1), cB + hstep + kstep, voffB);
        PG8_WAIT_V(6); PG8_BAR;
    } else {
        PG8_STAGE(PG8_SB(0, 0), cB, voffB); PG8_STAGE(PG8_SA(0, 0), cA, voffA); PG8_STAGE(PG8_SB(0, 1), cB + hstep, voffB); PG8_STAGE(PG8_SA(0, 1), cA + hstep, voffA);
        if (wr == 1) PG8_BAR;
        PG8_WAIT_V(4); PG8_BAR;
        PG8_STAGE(PG8_SB(1, 0), cB + kstep, voffB); PG8_STAGE(PG8_SA(1, 0), cA + kstep, voffA); PG8_STAGE(PG8_SB(1, 1), cB + hstep + kstep, voffB);
        PG8_WAIT_V(6); PG8_BAR;
    }
    for (;;) {
        const bool has_next = S.next(ui + 1, nxt);
        const char* nA = has_next ? (const char*)g.A + (size_t)nxt.pm * tstep : cA; const char* nB = has_next ? (const char*)g.Bt + (size_t)nxt.pn * tstep + ((nxt.pm >> 5) ? g.bstride : (size_t)0) : cB;
        for (int t = 0; t < nt; t += 2) {
            const bool last = (t == nt - 2);
            const char* a1 = cA + (size_t)(t + 1) * kstep;
            const char* a2 = last ? nA : cA + (size_t)(t + 2) * kstep; const char* b2 = last ? nB : cB + (size_t)(t + 2) * kstep;
            const char* a3 = a2 + kstep; const char* b3 = b2 + kstep;
            if (last && has_next) S.a_ready(nxt);
            if constexpr (SP2) {
            PG8_LDB(B0, 0, 0); PG8_LDB(B1, 0, 1); PG8_SCHED; PG8_LDA(At, 0, 0); PG8_STAGE(PG8_SA(1, 1), a1 + hstep, voffA);
            PG8_WAIT_V(8); PG8_WAIT_L(0); PG8_BAR; PG8_MMA(0, 0, At, B0); PG8_MMA(0, 1, At, B1); PG8_BAR; PG8_SCHED;
            PG8_LDA(At, 0, 1); PG8_STAGE(PG8_SB(0, 0), b2, voffB); PG8_STAGE(PG8_SB(0, 1), b2 + hstep, voffB); PG8_STAGE(PG8_SA(0, 0), a2, voffA);
            PG8_WAIT_V(8); PG8_WAIT_L(0); PG8_BAR; PG8_MMA(1, 0, At, B0); PG8_MMA(1, 1, At, B1); PG8_BAR; PG8_SCHED;
            PG8_LDB(B0, 1, 0); PG8_LDB(B1, 1, 1); PG8_SCHED; PG8_LDA(At, 1, 0); PG8_STAGE(PG8_SA(0, 1), a2 + hstep, voffA);
            PG8_WAIT_V(8); PG8_WAIT_L(0); PG8_BAR; PG8_MMA(0, 0, At, B0); PG8_MMA(0, 1, At, B1); PG8_BAR; PG8_SCHED;
            PG8_LDA(At, 1, 1); PG8_STAGE(PG8_SB(1, 0), b3, voffB); PG8_STAGE(PG8_SB(1, 1), b3 + hstep, voffB); PG8_STAGE(PG8_SA(1, 0), a3, voffA);
            PG8_WAIT_V(8); PG8_WAIT_L(0); PG8_BAR; PG8_MMA(1, 0, At, B0); PG8_MMA(1, 1, At, B1); PG8_BAR; PG8_SCHED;
            } else {
            PG8_LDB(B0, 0, 0); PG8_SCHED; PG8_LDA(At, 0, 0); PG8_STAGE(PG8_SA(1, 1), a1 + hstep, voffA);
            PG8_WAIT_L(8); PG8_BAR; PG8_WAIT_L(0); PG8_MMA(0, 0, At, B0); PG8_BAR; PG8_SCHED;
            PG8_LDB(B1, 0, 1); PG8_STAGE(PG8_SB(0, 0), b2, voffB);
            PG8_BAR; PG8_WAIT_L(0); PG8_MMA(0, 1, At, B1); PG8_BAR;
            PG8_LDA(At, 0, 1); PG8_STAGE(PG8_SA(0, 0), a2, voffA);
            PG8_BAR; PG8_WAIT_L(0); PG8_MMA(1, 0, At, B0); PG8_BAR; PG8_SCHED;
            PG8_STAGE(PG8_SB(0, 1), b2 + hstep, voffB);
            PG8_WAIT_V(6); PG8_BAR; PG8_MMA(1, 1, At, B1); PG8_BAR;
            PG8_LDB(B0, 1, 0); PG8_SCHED; PG8_LDA(At, 1, 0); PG8_STAGE(PG8_SA(0, 1), a2 + hstep, voffA);
            PG8_WAIT_L(8); PG8_BAR; PG8_WAIT_L(0); PG8_MMA(0, 0, At, B0); PG8_BAR; PG8_SCHED;
            PG8_LDB(B1, 1, 1); PG8_STAGE(PG8_SB(1, 0), b3, voffB);
            PG8_BAR; PG8_WAIT_L(0); PG8_MMA(0, 1, At, B1); PG8_BAR;
            PG8_LDA(At, 1, 1); PG8_STAGE(PG8_SA(1, 0), a3, voffA);
            PG8_BAR; PG8_WAIT_L(0); PG8_MMA(1, 0, At, B0); PG8_BAR; PG8_SCHED;
            PG8_STAGE(PG8_SB(1, 1), b3 + hstep, voffB);
            PG8_WAIT_V(6); PG8_BAR; PG8_MMA(1, 1, At, B1); PG8_BAR;
            }
        }
        if constexpr (ALIGN_EPI) { if (wr == 0) PG8_BAR; }
        if constexpr (!Epi::AFTER_DRAIN) { E(acc, cur, wr, wc, fr, fq); S.done(cur); }
        if (!has_next) break;
#pragma unroll
        for (int a = 0; a < 2; ++a)
#pragma unroll
            for (int b = 0; b < 2; ++b)
#pragma unroll
                for (int m = 0; m < 4; ++m)
#pragma unroll
                    for (int n = 0; n < 2; ++n) acc[a][b][m][n] = (f32x4){0.f, 0.f, 0.f, 0.f};
        cur = nxt; cA = nA; cB = nB; ++ui;
        if constexpr (ALIGN_EPI) { if (wr == 1) PG8_BAR; }
    }
    PG8_WAIT_V(0);
    if constexpr (!ALIGN_EPI) { if (wr == 0) PG8_BAR; }
    PG8_BAR;
    if constexpr (Epi::AFTER_DRAIN) { E.fused(acc, cur, wr, wc, fr, fq, lds, wid, lane); S.done(cur); }
#undef PG8_SA
#undef PG8_SB
#undef PG8_STAGE
#undef PG8_LDA
#undef PG8_LDB
#undef PG8_MMA
#undef PG8_WAIT_V
#undef PG8_WAIT_L
#undef PG8_BAR
#undef PG8_SCHED
}
}
#define GAS __attribute__((address_space(1)))
#define LAS __attribute__((address_space(3)))
typedef unsigned short bf16;
typedef unsigned v4u __attribute__((ext_vector_type(4)));
typedef float f32x4 __attribute__((ext_vector_type(4)));
typedef short bf16x8 __attribute__((ext_vector_type(8)));
typedef GAS unsigned gu32;
typedef GAS unsigned long long gu64;
#define RLX_AGENT __ATOMIC_RELAXED, __HIP_MEMORY_SCOPE_AGENT
#define LDS_WAIT() asm volatile("s_waitcnt lgkmcnt(0)" ::: "memory")
#define VM_WAIT() asm volatile("s_waitcnt vmcnt(0)" ::: "memory")
__device__ __forceinline__ unsigned long long rt() { return __builtin_amdgcn_s_memrealtime(); }
__device__ __forceinline__ unsigned f2bf(float f) { unsigned u = __builtin_bit_cast(unsigned, f); return (u + 0x7fffu + ((u >> 16) & 1u)) >> 16; }
__device__ __forceinline__ unsigned pk2(float lo, float hi) { unsigned r; asm("v_cvt_pk_bf16_f32 %0, %1, %2" : "=v"(r) : "v"(lo), "v"(hi)); return r; }

#define XB_TMO      128
#define XB_XCNT(j)  (256  + 64 * (j))
#define XB_XSUB(j)  (1280 + 64 * (j))
#define XB_XGEN(j)  (2304 + 64 * (j))
#define XB_TOP      3328
#define XB_TOPGEN   3392
#define XCD_BAR_WORDS 3456
#define XB_SPIN_CAP (1u << 18)

__device__ __forceinline__ unsigned xb_ld(unsigned* p)              { return __hip_atomic_load(p, __ATOMIC_RELAXED, __HIP_MEMORY_SCOPE_AGENT); }
__device__ __forceinline__ unsigned xb_add(unsigned* p, unsigned v) { return __hip_atomic_fetch_add(p, v, __ATOMIC_RELAXED, __HIP_MEMORY_SCOPE_AGENT); }
__device__ __forceinline__ unsigned xb_xcc_id() { return (unsigned)__builtin_amdgcn_s_getreg((3 << 11) | 20) & 0xFu; }
#define XB_SPIN(cond, bar) do { unsigned _sp = 0; while (cond) { __builtin_amdgcn_s_sleep(1); \
    if ((++_sp & 255u) == 0u) { if (xb_ld(&(bar)[XB_TMO])) break; if (_sp > XB_SPIN_CAP) { atomicAdd(&(bar)[XB_TMO], 1u); break; } } } } while (0)

struct XcdBarrier {
    unsigned* bar; unsigned x;
    volatile LAS unsigned* st;
};

__device__ __forceinline__ XcdBarrier xcd_barrier_post(unsigned* bar, volatile LAS unsigned* st) {
    XcdBarrier b; b.bar = bar; b.x = xb_xcc_id(); b.st = st;
    if (threadIdx.x == 0) (void)xb_add(&bar[XB_XCNT(b.x)], 1u);
    return b;
}
__device__ __forceinline__ void xcd_barrier_complete(unsigned* bar, unsigned x, unsigned& nloc, unsigned& nx) {
    const unsigned G = gridDim.x * gridDim.y * gridDim.z;
    unsigned sum, cnt, mine, sp = 0u;
    for (;;) {
        sum = 0u; cnt = 0u; mine = 0u;
#pragma unroll
        for (unsigned j = 0; j < 16; ++j) { const unsigned c = xb_ld(&bar[XB_XCNT(j)]); sum += c; cnt += (c > 0u) ? 1u : 0u; mine = (j == x) ? c : mine; }
        if (sum == G) break;
        __builtin_amdgcn_s_sleep(1);
        if ((++sp & 255u) == 0u) { if (xb_ld(&bar[XB_TMO])) break; if (sp > XB_SPIN_CAP) { atomicAdd(&bar[XB_TMO], 1u); break; } }
    }
    nloc = mine > 0u ? mine : 1u; nx = cnt > 0u ? cnt : 1u;
}

__device__ __forceinline__ void xcd_barrier(const XcdBarrier& b) {
    asm volatile("s_waitcnt vmcnt(0)" ::: "memory");
    __syncthreads();
    if (threadIdx.x == 0) {
        unsigned* bar = b.bar;
        __builtin_amdgcn_s_waitcnt(0);
        unsigned nloc = b.st[0], nx = b.st[1];
        if (nloc == 0u) { xcd_barrier_complete(bar, b.x, nloc, nx); b.st[0] = nloc; b.st[1] = nx; }
        const unsigned old = xb_add(&bar[XB_XSUB(b.x)], 1u);
        const unsigned gen = old / nloc;
        if (old + 1u == (gen + 1u) * nloc) {
            __builtin_amdgcn_fence(__ATOMIC_RELEASE, "agent");
            asm volatile("s_waitcnt vmcnt(0)" ::: "memory");
            const unsigned og = xb_add(&bar[XB_TOP], 1u);
            const unsigned tg = og / nx;
            if (og + 1u == (tg + 1u) * nx) xb_add(&bar[XB_TOPGEN], 1u);
            else XB_SPIN(xb_ld(&bar[XB_TOPGEN]) == tg, bar);
            __builtin_amdgcn_fence(__ATOMIC_ACQUIRE, "agent");
            xb_add(&bar[XB_XGEN(b.x)], 1u);
            asm volatile("s_waitcnt vmcnt(0)" ::: "memory");
        } else {
            XB_SPIN(xb_ld(&bar[XB_XGEN(b.x)]) == gen, bar);
            __builtin_amdgcn_fence(__ATOMIC_ACQUIRE, "agent");
            asm volatile("s_waitcnt vmcnt(0)" ::: "memory");
        }
    }
    __syncthreads();
}

constexpr int NWAVES = 8;
#ifndef MK_N_LAUNCHES
#define MK_N_LAUNCHES 1
#endif
constexpr int N_PHASES = 8;
constexpr int BATCH = 2, SEQ = 8192, DM = 2048, M = BATCH * SEQ, NPROJ = 4096, FFN = 5632, NGU = 2 * FFN, NMOD = 6 * DM;
constexpr float EPS = 1e-6f;
constexpr size_t MiB = 1u << 20;
constexpr size_t WS_CTL = 0, CTL_ZERO_BYTES = 128 * 1024;
constexpr size_t WS_MOD = 32 * 1024;
constexpr size_t WS_SSQK = 1 * MiB;
constexpr size_t WS_SS2 = 2 * MiB;
constexpr size_t WS_CB = 2 * MiB + 256 * 1024;
constexpr size_t WS_WIN = 4 * MiB, WS_WGLU = 20 * MiB, WS_WOUT = 22 * MiB, WS_WGU = 30 * MiB, WS_WD = 74 * MiB;
constexpr size_t WS_SC_W1 = 96 * MiB, WS_SC_CM = 104 * MiB, WS_SC_KT = 112 * MiB, WS_SC_A32 = 113 * MiB;
constexpr size_t WS_R = 130 * MiB;
constexpr size_t WS_UG = WS_R, WS_Q = WS_R + 32 * MiB, WS_K = WS_R + 64 * MiB, WS_V = WS_R + 96 * MiB, WS_YG = WS_R + 128 * MiB, WS_ATT = WS_R + 160 * MiB;
constexpr size_t WS_H1 = WS_R + 192 * MiB, WS_A2 = WS_R, WS_T = WS_R + 64 * MiB;
constexpr size_t WS_MIXED = 386 * MiB;
constexpr size_t WS_HS = 114 * MiB, WS_WGU1 = 450 * MiB, WS_CIS = 494 * MiB, WS_AML = 502 * MiB, WS_END = 505 * MiB;
constexpr int CW_TMO = 0, CW_CODE = 1, CW_Q = 64, CW_MODDONE = 320, CW_BAR = 4096;

constexpr int RING_OFF = 0, RING_BYTES = 131072;
constexpr int LDS_BYTES = 163840;
constexpr int LDSCTL_OFF = LDS_BYTES - 512, MISC_OFF = LDSCTL_OFF + 320;

struct Frame {
    LAS unsigned char* lds;
    volatile LAS unsigned* MISC;
    gu32* ctl;
    int tid, lane, wave, vcu, G;
    const float* in[22]; float* out; unsigned char* ws;
};
__device__ __forceinline__ float wave_sum(float v) {
#pragma unroll
    for (int o = 1; o < 64; o <<= 1) v += __shfl_xor(v, o);
    return v;
}
__device__ __forceinline__ float wave_max(float v) {
#pragma unroll
    for (int o = 1; o < 64; o <<= 1) v = fmaxf(v, __shfl_xor(v, o));
    return v;
}
__device__ __forceinline__ void p0_transpose_item(const float* W, int K, int N, bf16* WT, int mode, LAS float* scr, int item, int lane) {
    const int nblk = N / 32, kb = item / nblk, nb = item % nblk, k0 = 64 * kb, n0 = 32 * nb;
    float tv[32];
#pragma unroll
    for (int i = 0; i < 32; ++i) tv[i] = NT_LOAD(W + (size_t)(k0 + 2 * i + (lane >> 5)) * N + n0 + (lane & 31));
#pragma unroll
    for (int i = 0; i < 32; ++i) scr[(2 * i + (lane >> 5)) * 33 + (lane & 31)] = tv[i];
    LDS_WAIT(); asm volatile("" ::: "memory");
    const int c = lane & 7;
#pragma unroll
    for (int j = 0; j < 4; ++j) { const int n = (lane >> 3) + 8 * j; const LAS float* s = scr + (8 * c) * 33 + n;
        v4u o; o.x = pk2(s[0 * 33], s[1 * 33]); o.y = pk2(s[2 * 33], s[3 * 33]); o.z = pk2(s[4 * 33], s[5 * 33]); o.w = pk2(s[6 * 33], s[7 * 33]);
        const int ng = n0 + n; const int row = mode == 0 ? ng : ((ng >> 7) * 256 + (ng & 127) + (mode == 2 ? 128 : 0));
        *(GAS v4u*)(WT + (size_t)row * K + k0 + 8 * c) = o; }
    LDS_WAIT(); asm volatile("" ::: "memory");
}
#ifndef LATE_TR
#define LATE_TR 1
#endif
__device__ __forceinline__ void p0_transposes(Frame& F);
__device__ __forceinline__ void p0_prologue(Frame& F) {
    const float* cin = F.in[1]; const float* w_ada = F.in[2]; const float* b_ada = F.in[3];
    float* mod = (float*)(F.ws + WS_MOD);
    {   LAS float* sbuf = (LAS float*)(F.lds + RING_OFF); LAS float* obuf = (LAS float*)(F.lds + RING_OFF + 1024);
        for (int it = blockIdx.x; it < 192; it += F.G) { const int kc = it / 6, cc = it % 6;
            if (F.tid < 128) { const int b = F.tid >> 6, kk = F.tid & 63; const float cv = cin[b * DM + kc * 64 + kk]; sbuf[b * 64 + kk] = cv / (1.0f + __expf(-cv)); }
            __syncthreads();
            const int col = cc * 2048 + F.tid * 4; f32x4 a0 = {0.f, 0.f, 0.f, 0.f}, a1 = {0.f, 0.f, 0.f, 0.f};
#pragma unroll 8
            for (int kk = 0; kk < 64; ++kk) { const f32x4 w = NT_LOAD((const f32x4*)(w_ada + (size_t)(kc * 64 + kk) * NMOD + col)); a0 += w * sbuf[kk]; a1 += w * sbuf[64 + kk]; }
            if (kc == 0) { const f32x4 bb = *(const f32x4*)(b_ada + col); a0 += bb; a1 += bb; }
#pragma unroll
            for (int e = 0; e < 4; ++e) { obuf[F.tid * 4 + e] = a0[e]; obuf[2048 + F.tid * 4 + e] = a1[e]; }
            __syncthreads();
#pragma unroll
            for (int j = 0; j < 4; ++j) { atomicAdd(mod + cc * 2048 + F.tid + 512 * j, obuf[F.tid + 512 * j]); atomicAdd(mod + NMOD + cc * 2048 + F.tid + 512 * j, obuf[2048 + F.tid + 512 * j]); }
            asm volatile("s_waitcnt vmcnt(0)" ::: "memory");
            __syncthreads();
            if (F.tid == 0) { __builtin_amdgcn_fence(__ATOMIC_RELEASE, "agent"); asm volatile("s_waitcnt vmcnt(0)" ::: "memory");
                              __hip_atomic_fetch_add((unsigned*)(F.ctl + CW_MODDONE), 1u, __ATOMIC_RELAXED, __HIP_MEMORY_SCOPE_AGENT); }
        } }
}
__device__ __forceinline__ void wait_mod_done(Frame& F) {
    if (F.tid == 0) { unsigned sp = 0;
        while (__hip_atomic_load((unsigned*)(F.ctl + CW_MODDONE), __ATOMIC_RELAXED, __HIP_MEMORY_SCOPE_AGENT) < 192u) { __builtin_amdgcn_s_sleep(2); if (++sp > (1u << 22)) break; }
        __builtin_amdgcn_fence(__ATOMIC_ACQUIRE, "agent"); asm volatile("s_waitcnt vmcnt(0)" ::: "memory"); }
    __syncthreads();
}
__device__ __forceinline__ void p0_rest(Frame& F) {
    {   f32x4* z = (f32x4*)(F.ws + WS_SSQK); const f32x4 zero = {0.f, 0.f, 0.f, 0.f};
        for (int i = F.vcu * 512 + F.tid; i < 16 * 16384 / 4; i += F.G * 512) z[i] = zero;
        f32x4* z2 = (f32x4*)(F.ws + WS_SS2);
        for (int i = F.vcu * 512 + F.tid; i < 16384 / 4; i += F.G * 512) z2[i] = zero;
        f32x4* z3 = (f32x4*)(F.ws + WS_CB);
        for (int i = F.vcu * 512 + F.tid; i < 2 * NGU / 4; i += F.G * 512) z3[i] = zero; }
    p0_transposes(F);
}
__device__ __forceinline__ void p0_transposes(Frame& F) {
    __syncthreads();
    LAS float* scr = (LAS float*)(F.lds + RING_OFF + F.wave * 16384);
    const int gw = F.vcu * NWAVES + F.wave, NGW = F.G * NWAVES;
    constexpr int I_IN = (DM / 64) * (NPROJ / 32), I_GLU = (1024 / 64) * (1024 / 32), I_OUT = (DM / 64) * (DM / 32), I_D = (FFN / 64) * (DM / 32);
    constexpr int NITEMS = LATE_TR ? I_IN : I_IN + I_GLU + I_OUT + I_D;
    for (int it = gw; it < NITEMS; it += NGW) {
        int r = it;
        if (r < I_IN) { p0_transpose_item(F.in[5], DM, NPROJ, (bf16*)(F.ws + WS_WIN), 0, scr, r, F.lane); continue; } r -= I_IN;
        if (r < I_GLU) { p0_transpose_item(F.in[14], 1024, 1024, (bf16*)(F.ws + WS_WGLU), 0, scr, r, F.lane); continue; } r -= I_GLU;
        if (r < I_OUT) { p0_transpose_item(F.in[17], DM, DM, (bf16*)(F.ws + WS_WOUT), 0, scr, r, F.lane); continue; } r -= I_OUT;
        p0_transpose_item(F.in[21], FFN, DM, (bf16*)(F.ws + WS_WD), 0, scr, r, F.lane);
    }
}
__device__ __forceinline__ void gu_item(Frame& F, int it, int lane) {
    LAS float* scr = (LAS float*)(F.lds + RING_OFF + F.wave * 16384); LAS float* shs = scr + 2176;
    const float* n2w = F.in[18]; float* cb = (float*)(F.ws + WS_CB); const float* mod = (const float*)(F.ws + WS_MOD);
    bf16* WT0 = (bf16*)(F.ws + WS_WGU); bf16* WT1 = (bf16*)(F.ws + WS_WGU1);
    constexpr int I_G = (DM / 64) * (FFN / 32);
    { const int up = it >= I_G; const int item = it - up * I_G; const float* W = up ? F.in[20] : F.in[19];
            const int nblk = FFN / 32, kb = item / nblk, nb = item % nblk, k0 = 64 * kb, n0 = 32 * nb;
            float tv[32];
#pragma unroll
            for (int i = 0; i < 32; ++i) tv[i] = NT_LOAD(W + (size_t)(k0 + 2 * i + (lane >> 5)) * FFN + n0 + (lane & 31));
            const int c = lane & 7;
            const f32x4 nw0 = *(const f32x4*)(n2w + k0 + 8 * c), nw1 = *(const f32x4*)(n2w + k0 + 8 * c + 4);
            const f32x4 sa0 = *(const f32x4*)(mod + 4 * DM + k0 + 8 * c), sa1 = *(const f32x4*)(mod + 4 * DM + k0 + 8 * c + 4);
            const f32x4 sb0 = *(const f32x4*)(mod + NMOD + 4 * DM + k0 + 8 * c), sb1 = *(const f32x4*)(mod + NMOD + 4 * DM + k0 + 8 * c + 4);
            shs[lane] = mod[3 * DM + k0 + lane]; shs[64 + lane] = mod[NMOD + 3 * DM + k0 + lane];
#pragma unroll
            for (int i = 0; i < 32; ++i) scr[(2 * i + (lane >> 5)) * 33 + (lane & 31)] = tv[i];
            LDS_WAIT(); asm volatile("" ::: "memory");
            const f32x4 wa0 = nw0 * (sa0 + 1.0f), wa1 = nw1 * (sa1 + 1.0f), wb0 = nw0 * (sb0 + 1.0f), wb1 = nw1 * (sb1 + 1.0f);
#pragma unroll
            for (int j = 0; j < 4; ++j) { const int n = (lane >> 3) + 8 * j; const LAS float* sp = scr + (8 * c) * 33 + n;
                const float s0 = sp[0 * 33], s1 = sp[1 * 33], s2 = sp[2 * 33], s3 = sp[3 * 33], s4 = sp[4 * 33], s5 = sp[5 * 33], s6 = sp[6 * 33], s7 = sp[7 * 33];
                const int ng = n0 + n; const size_t row = (size_t)((ng >> 7) * 256 + (ng & 127) + up * 128);
                v4u o0, o1;
                o0.x = pk2(s0 * wa0[0], s1 * wa0[1]); o0.y = pk2(s2 * wa0[2], s3 * wa0[3]); o0.z = pk2(s4 * wa1[0], s5 * wa1[1]); o0.w = pk2(s6 * wa1[2], s7 * wa1[3]);
                o1.x = pk2(s0 * wb0[0], s1 * wb0[1]); o1.y = pk2(s2 * wb0[2], s3 * wb0[3]); o1.z = pk2(s4 * wb1[0], s5 * wb1[1]); o1.w = pk2(s6 * wb1[2], s7 * wb1[3]);
                *(GAS v4u*)(WT0 + row * DM + k0 + 8 * c) = o0; *(GAS v4u*)(WT1 + row * DM + k0 + 8 * c) = o1; }
            { const int n = lane & 31, b = lane >> 5; float a = 0.f;
#pragma unroll 16
              for (int k = 0; k < 64; ++k) a += shs[b * 64 + k] * scr[k * 33 + n];
              const int ng = n0 + n; atomicAdd(cb + b * NGU + (ng >> 7) * 256 + (ng & 127) + up * 128, a); }
            LDS_WAIT(); asm volatile("" ::: "memory"); }
}
constexpr int TR_IG = (DM / 64) * (FFN / 32), TR_GLU = (1024 / 64) * (1024 / 32), TR_OUT = (DM / 64) * (DM / 32), TR_D = (FFN / 64) * (DM / 32), TR_TOTAL = 2 * TR_IG + TR_GLU + TR_OUT + TR_D;
__device__ __forceinline__ void tr_wave_item(Frame& F, int it, int lane) {
    LAS float* scr = (LAS float*)(F.lds + RING_OFF + F.wave * 16384);
    if (it < 2 * TR_IG) { gu_item(F, it, lane); return; } it -= 2 * TR_IG;
    if (it < TR_GLU) { p0_transpose_item(F.in[14], 1024, 1024, (bf16*)(F.ws + WS_WGLU), 0, scr, it, lane); return; } it -= TR_GLU;
    if (it < TR_OUT) { p0_transpose_item(F.in[17], DM, DM, (bf16*)(F.ws + WS_WOUT), 0, scr, it, lane); return; } it -= TR_OUT;
    p0_transpose_item(F.in[21], FFN, DM, (bf16*)(F.ws + WS_WD), 0, scr, it, lane);
}
__device__ __forceinline__ void p1_norm1(Frame& F) {
    const int gw = F.vcu * NWAVES + F.wave, NGW = F.G * NWAVES;
    const float* x = F.in[0]; const float* n1w = F.in[4]; const float* mod = (const float*)(F.ws + WS_MOD);
    bf16* h1 = (bf16*)(F.ws + WS_H1);
    const bool blocked = (M % (2 * NGW)) == 0; const int rpw = M / NGW;
    const int m_begin = blocked ? gw * rpw : gw, m_end = blocked ? (gw + 1) * rpw : M, m_step = blocked ? 2 : 2 * NGW, m_pair = blocked ? 1 : NGW;
    {   const int ln = F.lane;
        f32x4 wv[8], shv[8]; int bcur = -1;
        f32x4 v0[8], v1[8];
        int m0 = m_begin;
        if (m0 < m_end) { const int m1 = (m0 + m_pair < M) ? m0 + m_pair : m0;
            const GAS f32x4* xr0 = (const GAS f32x4*)(x + (size_t)m0 * DM) + ln; const GAS f32x4* xr1 = (const GAS f32x4*)(x + (size_t)m1 * DM) + ln;
#pragma unroll
            for (int j = 0; j < 8; ++j) { v0[j] = NT_LOADA(xr0 + 64 * j); v1[j] = NT_LOADA(xr1 + 64 * j); } }
        for (; m0 < m_end; m0 += m_step) {
            const int m1 = m0 + m_pair; const bool has1 = m1 < M; const int b0 = m0 >> 13, b1 = (has1 ? m1 : m0) >> 13;
            if (b0 != bcur) { bcur = b0;
#pragma unroll
                for (int j = 0; j < 8; ++j) { const int col = 4 * ln + 256 * j; wv[j] = *(const f32x4*)(n1w + col) * (*(const f32x4*)(mod + b0 * NMOD + DM + col) + 1.0f); shv[j] = *(const f32x4*)(mod + b0 * NMOD + col); } }
            float s0 = 0.f, s1 = 0.f;
#pragma unroll
            for (int j = 0; j < 8; ++j) { s0 += (v0[j].x * v0[j].x + v0[j].y * v0[j].y) + (v0[j].z * v0[j].z + v0[j].w * v0[j].w); s1 += (v1[j].x * v1[j].x + v1[j].y * v1[j].y) + (v1[j].z * v1[j].z + v1[j].w * v1[j].w); }
            const float r0 = __builtin_amdgcn_rsqf(wave_sum(s0) * (1.0f / DM) + EPS), r1 = __builtin_amdgcn_rsqf(wave_sum(s1) * (1.0f / DM) + EPS);
            unsigned long long h0[8], h1v[8];
#pragma unroll
            for (int j = 0; j < 8; ++j) { const f32x4 ha = v0[j] * r0 * wv[j] + shv[j]; h0[j] = (unsigned long long)pk2(ha.x, ha.y) | ((unsigned long long)pk2(ha.z, ha.w) << 32); }
            if (b1 == b0) {
#pragma unroll
                for (int j = 0; j < 8; ++j) { const f32x4 hb = v1[j] * r1 * wv[j] + shv[j]; h1v[j] = (unsigned long long)pk2(hb.x, hb.y) | ((unsigned long long)pk2(hb.z, hb.w) << 32); }
            } else {
#pragma unroll
                for (int j = 0; j < 8; ++j) { const int col = 4 * ln + 256 * j; const f32x4 hb = v1[j] * r1 * (*(const f32x4*)(n1w + col) * (*(const f32x4*)(mod + b1 * NMOD + DM + col) + 1.0f)) + *(const f32x4*)(mod + b1 * NMOD + col);
                    h1v[j] = (unsigned long long)pk2(hb.x, hb.y) | ((unsigned long long)pk2(hb.z, hb.w) << 32); } }
            const int n0 = m0 + m_step;
            if (n0 < m_end) { const int n1 = (n0 + m_pair < M) ? n0 + m_pair : n0;
                const GAS f32x4* xr0 = (const GAS f32x4*)(x + (size_t)n0 * DM) + ln; const GAS f32x4* xr1 = (const GAS f32x4*)(x + (size_t)n1 * DM) + ln;
#pragma unroll
                for (int j = 0; j < 8; ++j) { v0[j] = NT_LOADA(xr0 + 64 * j); v1[j] = NT_LOADA(xr1 + 64 * j); } }
            asm volatile("" ::: "memory");
            GAS unsigned long long* o0 = (GAS unsigned long long*)(h1 + (size_t)m0 * DM) + ln; GAS unsigned long long* o1 = (GAS unsigned long long*)(h1 + (size_t)(has1 ? m1 : m0) * DM) + ln;
#pragma unroll
            for (int j = 0; j < 8; ++j) { o0[64 * j] = h0[j]; if (has1) o1[64 * j] = h1v[j]; }
            asm volatile("" ::: "memory");
        } }
    if (!LATE_TR) for (int it = gw; it < 2 * TR_IG; it += NGW) gu_item(F, it, F.lane);
}
__device__ __forceinline__ float gelu_tanh(float y) { const float y2 = y * y; const float w = y * (-2.302208198f - 0.1029432397f * y2);
    return y * __builtin_amdgcn_rcpf(1.0f + __builtin_amdgcn_exp2f(w)); }
__device__ __forceinline__ void p3_ssm_naive(Frame& F) {
    if (F.wave == 0) {
        const bf16* ug = (const bf16*)(F.ws + WS_UG); bf16* yg = (bf16*)(F.ws + WS_YG);
        for (int it = blockIdx.x; it < 128; it += F.G) { const int b = it >> 6, g = it & 63, n = F.lane;
            const float dt = expf(F.in[8][g]), are = F.in[6][g * 64 + n], aim = F.in[7][g * 64 + n];
            const float mag = expf(are * dt), abr = mag * cosf(aim * dt), abi = mag * sinf(aim * dt);
            const float nre = abr - 1.0f, nim = abi, den = are * are + aim * aim;
            const float zre = (nre * are + nim * aim) / den, zim = (nim * are - nre * aim) / den;
            float bbr[16], bbi[16], cre[16], cim[16];
#pragma unroll
            for (int c = 0; c < 16; ++c) { const float br = F.in[9][(g * 64 + n) * 16 + c], bi = F.in[10][(g * 64 + n) * 16 + c];
                bbr[c] = zre * br - zim * bi; bbi[c] = zre * bi + zim * br;
                cre[c] = F.in[11][(g * 16 + c) * 64 + n]; cim[c] = F.in[12][(g * 16 + c) * 64 + n]; }
            const float dl = F.in[13][g * 16 + (F.lane & 15)];
            float hr = 0.f, hi = 0.f;
            const bf16* up = ug + (size_t)((b * 64 + g) * 8192) * 16;
            for (int t = 0; t < SEQ; ++t) {
                const v4u w0 = *(const v4u*)(up + (size_t)t * 16), w1 = *(const v4u*)(up + (size_t)t * 16 + 8);
                const float u[16] = {__uint_as_float(w0.x << 16), __uint_as_float(w0.x & 0xffff0000u), __uint_as_float(w0.y << 16), __uint_as_float(w0.y & 0xffff0000u),
                                     __uint_as_float(w0.z << 16), __uint_as_float(w0.z & 0xffff0000u), __uint_as_float(w0.w << 16), __uint_as_float(w0.w & 0xffff0000u),
                                     __uint_as_float(w1.x << 16), __uint_as_float(w1.x & 0xffff0000u), __uint_as_float(w1.y << 16), __uint_as_float(w1.y & 0xffff0000u),
                                     __uint_as_float(w1.z << 16), __uint_as_float(w1.z & 0xffff0000u), __uint_as_float(w1.w << 16), __uint_as_float(w1.w & 0xffff0000u)};
                float bur = 0.f, bui = 0.f;
#pragma unroll
                for (int c = 0; c < 16; ++c) { bur += bbr[c] * u[c]; bui += bbi[c] * u[c]; }
                const float nr = abr * hr - abi * hi + bur, ni = abr * hi + abi * hr + bui; hr = nr; hi = ni;
                float yv = 0.f, ul = 0.f;
#pragma unroll
                for (int c = 0; c < 16; ++c) { const float p = wave_sum(hr * cre[c] - hi * cim[c]); if ((F.lane & 15) == c) { yv = p; ul = u[c]; } }
                yv += dl * ul;
                if (F.lane < 16) { const float gl = gelu_tanh(yv); yg[(size_t)(b * SEQ + t) * 1024 + g * 16 + F.lane] = (bf16)f2bf(gl); }
            } }
    }
}
__device__ __forceinline__ void p3_attn_naive(Frame& F) {
    const int gw = F.vcu * NWAVES + F.wave, NGW = F.G * NWAVES;
    const bf16* qb = (const bf16*)(F.ws + WS_Q); const bf16* kb = (const bf16*)(F.ws + WS_K); const bf16* vb = (const bf16*)(F.ws + WS_V);
    const float* ssqk = (const float*)(F.ws + WS_SSQK); bf16* mixed = (bf16*)(F.ws + WS_MIXED);
    LAS float* qw = (LAS float*)(F.lds + RING_OFF + F.wave * 1024);
    const float wq0 = F.in[15][2 * F.lane], wq1 = F.in[15][2 * F.lane + 1], wk0 = F.in[16][2 * F.lane], wk1 = F.in[16][2 * F.lane + 1];
    for (int it = gw; it < M * 8; it += NGW) { const int h = it & 7, bt = it >> 3, t = bt & (SEQ - 1), b = bt >> 13;
        const float slope = exp2f(-(float)(h + 1));
        const unsigned qraw = *(const unsigned*)(qb + (size_t)bt * 1024 + h * 128 + 2 * F.lane);
        const float rq = 1.0f / sqrtf(ssqk[(size_t)h * 16384 + bt] * (1.0f / 128.0f) + EPS) * 0.08838834764831845f;
        asm volatile("s_waitcnt lgkmcnt(0)" ::: "memory");
        qw[2 * F.lane] = __uint_as_float(qraw << 16) * rq * wq0 * wk0; qw[2 * F.lane + 1] = __uint_as_float(qraw & 0xffff0000u) * rq * wq1 * wk1;
        asm volatile("s_waitcnt lgkmcnt(0)" ::: "memory");
        float sc[7]; int kt[7]; float mx = -1e30f;
#pragma unroll
        for (int i = 0; i < 7; ++i) { const int p = F.lane + 64 * i; const int br = p / 129, j = p - br * 129; const int dil = br == 0 ? 1 : (br == 1 ? 4 : 16);
            const int kk = t - dil * j; const bool valid = (p < 387) && (kk >= 0); kt[i] = valid ? kk : -1; sc[i] = -1e30f;
            if (valid) { const size_t kr = (size_t)(b * SEQ + kk);
                const v4u* kp = (const v4u*)(kb + kr * 1024 + h * 128); float d = 0.f;
#pragma unroll
                for (int c = 0; c < 16; ++c) { const v4u w = kp[c]; const LAS float* qq = qw + 8 * c;
                    d += __uint_as_float(w.x << 16) * qq[0] + __uint_as_float(w.x & 0xffff0000u) * qq[1] + __uint_as_float(w.y << 16) * qq[2] + __uint_as_float(w.y & 0xffff0000u) * qq[3]
                       + __uint_as_float(w.z << 16) * qq[4] + __uint_as_float(w.z & 0xffff0000u) * qq[5] + __uint_as_float(w.w << 16) * qq[6] + __uint_as_float(w.w & 0xffff0000u) * qq[7]; }
                const float rk = 1.0f / sqrtf(ssqk[(size_t)(8 + h) * 16384 + kr] * (1.0f / 128.0f) + EPS);
                sc[i] = d * rk - slope * (float)(dil * j); mx = fmaxf(mx, sc[i]); } }
        mx = wave_max(mx);
        float ls = 0.f;
#pragma unroll
        for (int i = 0; i < 7; ++i) { sc[i] = kt[i] >= 0 ? __expf(sc[i] - mx) : 0.f; ls += sc[i]; }
        ls = wave_sum(ls);
        float o0 = 0.f, o1 = 0.f;
#pragma unroll
        for (int i = 0; i < 7; ++i)
            for (int src = 0; src < 64; ++src) { const float p = __shfl(sc[i], src); const int kk = __shfl(kt[i], src);
                if (kk >= 0) { const unsigned vv = *(const unsigned*)(vb + (size_t)(b * SEQ + kk) * 1024 + h * 128 + 2 * F.lane); o0 += p * __uint_as_float(vv << 16); o1 += p * __uint_as_float(vv & 0xffff0000u); } }
        const float rl = 1.0f / ls;
        *(unsigned*)(mixed + (size_t)bt * 2048 + 1024 + h * 128 + 2 * F.lane) = pk2(o0 * rl, o1 * rl);
    }
}


namespace att {
typedef short bf16x8 __attribute__((ext_vector_type(8)));
typedef short s16x4 __attribute__((ext_vector_type(4)));
typedef float f32x16 __attribute__((ext_vector_type(16)));
typedef float f32x2 __attribute__((ext_vector_type(2)));
typedef unsigned u32x4 __attribute__((ext_vector_type(4)));
typedef short v4i16_t __attribute__((ext_vector_type(4)));
constexpr int WAVE_LDS = 17408;
constexpr int WQK_OFF = 162816;
__device__ __forceinline__ int crow(int r, int hi) { return (r & 3) + 8 * (r >> 2) + 4 * hi; }
__device__ __forceinline__ int v_st(int k, int c) { const int kk = (k & ~0xC) | ((k & 4) << 1) | ((k & 8) >> 1); return ((kk >> 3) * 4 + (c >> 5)) * 512 + ((kk & 7) * 32 + (c & 31)) * 2; }
__device__ __forceinline__ int v_rd_base(int lane) { return ((lane & 3) << 3) | (((lane >> 2) & 3) << 6) | (((lane >> 4) & 1) << 5) | (((lane >> 5) & 1) << 8); }
constexpr int v_rd_off(int d0, int ks, int half) { return d0 * 512 + ks * 4096 + half * 2048; }
__device__ __forceinline__ unsigned cvtpk(float lo, float hi) { unsigned r; asm volatile("v_cvt_pk_bf16_f32 %0, %1, %2" : "=v"(r) : "v"(lo), "v"(hi)); return r; }
__device__ __forceinline__ s16x4 vtr(const LAS char* p) { return __builtin_bit_cast(s16x4, __builtin_amdgcn_ds_read_tr16_b64_v4i16((LAS v4i16_t*)p)); }

struct Ptrs { const bf16* q; const bf16* k; const bf16* v; const float* ssqk; bf16* ao; float* aml; unsigned* probe; };

__device__ __forceinline__ void task(const Ptrs& T, int br, int b, int h, int res, int Pq0, LAS char* wl, const LAS float* wqk, int lane) {
    const int r32 = lane & 31, hi = lane >> 5;
    const int dil = br == 0 ? 1 : (br == 1 ? 4 : 16);
    const size_t rowbase = (size_t)b * SEQ;
    const float* ssq = T.ssqk + (size_t)h * 16384 + rowbase; const float* ssk = T.ssqk + (size_t)(8 + h) * 16384 + rowbase;
    LAS float* rkb = (LAS float*)(wl + 16384); LAS float* lib = rkb + 160;
#pragma unroll
    for (int i = 0; i < 3; ++i) { const int kp = 64 * i + lane; if (kp < 160) { int P = Pq0 - 128 + kp; P = P < 0 ? 0 : P; rkb[kp] = 1.0f / sqrtf(ssk[dil * P + res] * (1.0f / 128.0f) + EPS); } }
    const int tq = dil * (Pq0 + r32) + res;
    const float rq = (0.08838834764831845f * 1.4426950408889634f) / sqrtf(ssq[tq] * (1.0f / 128.0f) + EPS);
    bf16x8 qr[8];
    { const bf16* qp = T.q + (rowbase + tq) * 1024 + h * 128 + 8 * hi;
#pragma unroll
      for (int ds = 0; ds < 8; ++ds) { const u32x4 w = *(const u32x4*)(qp + 16 * ds);
          const f32x4 wa = *(const LAS f32x4*)(wqk + 16 * ds + 8 * hi), wb = *(const LAS f32x4*)(wqk + 16 * ds + 8 * hi + 4);
          u32x4 o; o.x = cvtpk(__uint_as_float(w.x << 16) * rq * wa[0], __uint_as_float(w.x & 0xffff0000u) * rq * wa[1]);
          o.y = cvtpk(__uint_as_float(w.y << 16) * rq * wa[2], __uint_as_float(w.y & 0xffff0000u) * rq * wa[3]);
          o.z = cvtpk(__uint_as_float(w.z << 16) * rq * wb[0], __uint_as_float(w.z & 0xffff0000u) * rq * wb[1]);
          o.w = cvtpk(__uint_as_float(w.w << 16) * rq * wb[2], __uint_as_float(w.w & 0xffff0000u) * rq * wb[3]);
          qr[ds] = __builtin_bit_cast(bf16x8, o); } }
    f32x16 p[5];
    bf16x8 kfa[8], kfb[8];
#define ATT_KLOAD(KF, t_) do { int P = Pq0 - 128 + 32 * (t_) + r32; P = P < 0 ? 0 : P; const bf16* kp = T.k + (rowbase + dil * P + res) * 1024 + h * 128 + 8 * hi; \
        _Pragma("unroll") for (int ds = 0; ds < 8; ++ds) KF[ds] = *(const bf16x8*)(kp + 16 * ds); } while (0)
#define ATT_QK(KF, t_) do { f32x16 a = {}; _Pragma("unroll") for (int ds = 0; ds < 8; ++ds) a = __builtin_amdgcn_mfma_f32_32x32x16_bf16(KF[ds], qr[ds], a, 0, 0, 0); p[t_] = a; } while (0)
    ATT_KLOAD(kfa, 0); asm volatile("" ::: "memory");
    ATT_KLOAD(kfb, 1); asm volatile("" ::: "memory"); ATT_QK(kfa, 0);
    ATT_KLOAD(kfa, 2); asm volatile("" ::: "memory"); ATT_QK(kfb, 1);
    ATT_KLOAD(kfb, 3); asm volatile("" ::: "memory"); ATT_QK(kfa, 2);
    ATT_KLOAD(kfa, 4); asm volatile("" ::: "memory"); ATT_QK(kfb, 3);
    ATT_QK(kfa, 4);
#undef ATT_KLOAD
#undef ATT_QK
    const float cb = exp2f(-(float)(h + 1)) * (float)dil * 1.4426950408889634f;
    const float NEG = -__builtin_inff();
    float mx = NEG;
#pragma unroll
    for (int t = 0; t < 5; ++t) {
        f32x4 rk4[4];
#pragma unroll
        for (int g4 = 0; g4 < 4; ++g4) rk4[g4] = *(const LAS f32x4*)(rkb + 32 * t + 8 * g4 + 4 * hi);
#pragma unroll
        for (int r = 0; r < 16; ++r) { const int kk = (r & 3) + 8 * (r >> 2) + 4 * hi;
            const float s = p[t][r] * rk4[r >> 2][r & 3] + cb * (float)(kk + 32 * t - 128 - r32);
            bool valid = (Pq0 - 128 + 32 * t + kk) >= 0;
            if (t == 0) valid = valid && (kk >= r32);
            if (t == 4) valid = valid && (kk <= r32);
            const float sv = valid ? s : NEG; p[t][r] = sv; mx = fmaxf(mx, sv); } }
    { auto rr = __builtin_amdgcn_permlane32_swap(__float_as_uint(mx), __float_as_uint(mx), false, false); mx = fmaxf(__uint_as_float(rr[0]), __uint_as_float(rr[1])); }
    float ls = 0.f;
    bf16x8 pa[5][2];
#define ATT_PK4(P, B_, OUT) do { unsigned a0 = cvtpk(P[B_ + 0], P[B_ + 1]), a1 = cvtpk(P[B_ + 2], P[B_ + 3]); unsigned b0 = cvtpk(P[B_ + 4], P[B_ + 5]), b1 = cvtpk(P[B_ + 6], P[B_ + 7]); \
        auto r0 = __builtin_amdgcn_permlane32_swap(a0, b0, false, false); auto r1 = __builtin_amdgcn_permlane32_swap(a1, b1, false, false); \
        u32x4 w = {r0[0], r1[0], r0[1], r1[1]}; OUT = __builtin_bit_cast(bf16x8, w); } while (0)
#pragma unroll
    for (int t = 0; t < 5; ++t) {
#pragma unroll
        for (int r = 0; r < 16; ++r) { const float e = __builtin_amdgcn_exp2f(p[t][r] - mx); p[t][r] = e; ls += e; }
        ATT_PK4(p[t], 0, pa[t][0]); ATT_PK4(p[t], 8, pa[t][1]); }
#undef ATT_PK4
    { auto rr = __builtin_amdgcn_permlane32_swap(__float_as_uint(ls), __float_as_uint(ls), false, false); ls = __uint_as_float(rr[0]) + __uint_as_float(rr[1]); }
    f32x16 o[4] = {};
    const int sr = lane >> 4, sc = (lane & 15) * 8;
    const LAS char* vrd = wl + v_rd_base(lane);
    u32x4 vs[8];
#define ATT_VLOAD(t_) do { _Pragma("unroll") for (int i = 0; i < 8; ++i) { int P = Pq0 - 128 + 32 * (t_) + sr + 4 * i; P = P < 0 ? 0 : P; \
        vs[i] = *(const u32x4*)(T.v + (rowbase + dil * P + res) * 1024 + h * 128 + sc); } } while (0)
#define ATT_VWRITE(t_) do { _Pragma("unroll") for (int i = 0; i < 8; ++i) *(LAS u32x4*)(wl + ((t_) & 1) * 8192 + v_st(sr + 4 * i, sc)) = vs[i]; } while (0)
    ATT_VLOAD(0); ATT_VWRITE(0);
    __builtin_amdgcn_sched_barrier(0);
#pragma unroll
    for (int t = 0; t < 5; ++t) {
        if (t + 1 < 5) ATT_VLOAD(t + 1);
        const bf16x8 pa0 = pa[t][0], pa1 = pa[t][1];
        const LAS char* vb = vrd + (t & 1) * 8192;
#pragma unroll
        for (int d0 = 0; d0 < 4; ++d0) {
            const s16x4 l0 = vtr(vb + v_rd_off(d0, 0, 0)), h0 = vtr(vb + v_rd_off(d0, 0, 1)), l1 = vtr(vb + v_rd_off(d0, 1, 0)), h1 = vtr(vb + v_rd_off(d0, 1, 1));
            o[d0] = __builtin_amdgcn_mfma_f32_32x32x16_bf16(pa0, (bf16x8){l0[0], l0[1], l0[2], l0[3], h0[0], h0[1], h0[2], h0[3]}, o[d0], 0, 0, 0);
            o[d0] = __builtin_amdgcn_mfma_f32_32x32x16_bf16(pa1, (bf16x8){l1[0], l1[1], l1[2], l1[3], h1[0], h1[1], h1[2], h1[3]}, o[d0], 0, 0, 0); }
        if (t + 1 < 5) ATT_VWRITE(t + 1);
        __builtin_amdgcn_sched_barrier(0);
    }
#undef ATT_VLOAD
#undef ATT_VWRITE
    if (hi == 0) { lib[r32] = ls; *(f32x2*)(T.aml + ((size_t)br * M + rowbase + tq) * 16 + 2 * h) = (f32x2){mx, ls}; }
    bf16* ao = T.ao + (size_t)br * M * 1024;
#pragma unroll
    for (int r = 0; r < 16; ++r) { const int orow = crow(r, hi); const float rl = 1.0f / lib[orow];
        bf16* op = ao + (rowbase + dil * (Pq0 + orow) + res) * 1024 + h * 128 + r32;
#pragma unroll
        for (int d0 = 0; d0 < 4; ++d0) { const float v = o[d0][r] * rl; const float vn = __shfl_xor(v, 1);
            if ((r32 & 1) == 0) *(unsigned*)(op + d0 * 32) = cvtpk(v, vn); } }
}
__device__ __forceinline__ void unit(const Ptrs& T, int u, LAS char* lds, int wave, int lane) {
    const int br = u >> 9, rem = u & 511, bh = rem >> 5, x = rem & 31;
    const int upr = br == 0 ? 32 : (br == 1 ? 8 : 2);
    const int res = x / upr, pb8 = x % upr;
    task(T, br, bh >> 3, bh & 7, res, 32 * (pb8 * 8 + wave), lds + wave * WAVE_LDS, (const LAS float*)(lds + WQK_OFF), lane);
}

constexpr int CO_RK = 98304, CO_LI = CO_RK + 1536, CO_OST = CO_LI + 1024;
#ifndef ATT_PF
#define ATT_PF 8
#endif
#define ATT_KSWZ(row, colB) ((row) * 256 + ((colB) ^ (((row) & 7) << 4)))
struct UnitId { int br, b, h, res, Pu0, dil; };
__device__ __forceinline__ UnitId decode(int u) { UnitId d; d.br = u >> 9; const int rem = u & 511, bh = rem >> 5, x = rem & 31; const int upr = d.br == 0 ? 32 : (d.br == 1 ? 8 : 2);
    d.b = bh >> 3; d.h = bh & 7; d.res = x / upr; d.Pu0 = 256 * (x % upr); d.dil = d.br == 0 ? 1 : (d.br == 1 ? 4 : 16); return d; }
template <int I0 = 0, int I1 = 12>
__device__ __forceinline__ void stage_load(u32x4 (&st)[12], const bf16* base, const UnitId& d, int tid) {
    const bf16* p = base + ((size_t)d.b * SEQ) * 1024 + d.h * 128 + (tid & 15) * 8;
#pragma unroll
    for (int i = I0; i < I1; ++i) { int P = d.Pu0 - 128 + (tid >> 4) + 32 * i; P = P < 0 ? 0 : P; st[i] = NT_LOADKV((const u32x4*)(p + (size_t)(d.dil * P + d.res) * 1024)); }
}
__device__ __forceinline__ void stage_write_k(const u32x4 (&st)[12], LAS char* lds, int tid) {
    const int r = tid >> 4, cb = (tid & 15) * 16;
#pragma unroll
    for (int i = 0; i < 12; ++i) *(LAS u32x4*)(lds + i * 8192 + ATT_KSWZ(r, cb)) = st[i];
}
__device__ __forceinline__ void stage_write_v(const u32x4 (&st)[12], LAS char* lds, int tid) {
    const int r = tid >> 4, c = (tid & 15) * 8;
#pragma unroll
    for (int i = 0; i < 12; ++i) *(LAS u32x4*)(lds + i * 8192 + v_st(r, c)) = st[i];
}
struct Carry { u32x4 kst[12]; float rk_raw, ssq_raw; };
__device__ __forceinline__ void carry_load_rest(Carry& c, const Ptrs& T, const UnitId& d, int tid, int wave, int lane) {
    const size_t rowbase = (size_t)d.b * SEQ; const int r32 = lane & 31;
    const int tq = d.dil * (d.Pu0 + 32 * wave + r32) + d.res;
    c.ssq_raw = T.ssqk[(size_t)d.h * 16384 + rowbase + tq];
    int P = d.Pu0 - 128 + (tid < 384 ? tid : 0); P = P < 0 ? 0 : P;
    c.rk_raw = T.ssqk[(size_t)(8 + d.h) * 16384 + rowbase + d.dil * P + d.res];
}
template <class Fetch>
__device__ __forceinline__ int unit_co(const Ptrs& T, int u, Carry& c, LAS char* lds, int tid, int wave, int lane, int n_ssm, int n_total, const Fetch& fetch_next) {
#ifdef PROBE_ATT
    unsigned long long ts_[8]; int nst_ = 0;
#define ATT_STAMP() do { __builtin_amdgcn_sched_barrier(0); ts_[nst_++] = __builtin_amdgcn_s_memrealtime(); __builtin_amdgcn_sched_barrier(0); } while (0)
#else
#define ATT_STAMP() do {} while (0)
#endif
    ATT_STAMP();
    const UnitId d = decode(u);
    const unsigned nxt_raw = fetch_next.issue();
    const int r32 = lane & 31, hi = lane >> 5;
    const size_t rowbase = (size_t)d.b * SEQ;
    const LAS float* wqk = (const LAS float*)(lds + WQK_OFF);
    LAS float* rkb = (LAS float*)(lds + CO_RK); LAS float* lib = (LAS float*)(lds + CO_LI) + wave * 32;
    const int Pq0 = d.Pu0 + 32 * wave;
    const int tq = d.dil * (Pq0 + r32) + d.res;
    stage_load<8, 12>(c.kst, T.k, d, tid);
    stage_write_k(c.kst, lds, tid);
    __builtin_amdgcn_sched_barrier(0);
    u32x4 qraw[8];
    { const bf16* qp = T.q + (rowbase + tq) * 1024 + d.h * 128 + 8 * hi;
#pragma unroll
      for (int ds = 0; ds < 8; ++ds) qraw[ds] = *(const u32x4*)(qp + 16 * ds); }
    if (tid < 384) rkb[tid] = 1.0f / sqrtf(c.rk_raw * (1.0f / 128.0f) + EPS);
    __syncthreads();
    ATT_STAMP();
    const float rq = (0.08838834764831845f * 1.4426950408889634f) / sqrtf(c.ssq_raw * (1.0f / 128.0f) + EPS);
    bf16x8 qr[8];
#pragma unroll
    for (int ds = 0; ds < 8; ++ds) { const u32x4 w = qraw[ds];
        const f32x4 wa = *(const LAS f32x4*)(wqk + 16 * ds + 8 * hi), wb = *(const LAS f32x4*)(wqk + 16 * ds + 8 * hi + 4);
        u32x4 o; o.x = cvtpk(__uint_as_float(w.x << 16) * rq * wa[0], __uint_as_float(w.x & 0xffff0000u) * rq * wa[1]);
        o.y = cvtpk(__uint_as_float(w.y << 16) * rq * wa[2], __uint_as_float(w.y & 0xffff0000u) * rq * wa[3]);
        o.z = cvtpk(__uint_as_float(w.z << 16) * rq * wb[0], __uint_as_float(w.z & 0xffff0000u) * rq * wb[1]);
        o.w = cvtpk(__uint_as_float(w.w << 16) * rq * wb[2], __uint_as_float(w.w & 0xffff0000u) * rq * wb[3]);
        qr[ds] = __builtin_bit_cast(bf16x8, o); }
    f32x16 p[5];
    { const LAS char* kw = lds + wave * 8192;
      const LAS char* kb0 = kw + ATT_KSWZ(r32, (0 * 16 + hi * 8) * 2); const LAS char* kb1 = kw + ATT_KSWZ(r32, (1 * 16 + hi * 8) * 2);
      const LAS char* kb2 = kw + ATT_KSWZ(r32, (2 * 16 + hi * 8) * 2); const LAS char* kb3 = kw + ATT_KSWZ(r32, (3 * 16 + hi * 8) * 2);
#pragma unroll
      for (int t = 0; t < 5; ++t) { f32x16 a = {};
#pragma unroll
          for (int ds = 0; ds < 8; ++ds) { const LAS char* kp = ((ds & 3) == 0 ? kb0 : (ds & 3) == 1 ? kb1 : (ds & 3) == 2 ? kb2 : kb3) + t * 8192 + (ds >> 2) * 128;
              a = __builtin_amdgcn_mfma_f32_32x32x16_bf16(*(const LAS bf16x8*)kp, qr[ds], a, 0, 0, 0); }
          p[t] = a; if (t & 1) __builtin_amdgcn_sched_barrier(0); } }
    ATT_STAMP();
    u32x4 vst[12];
    stage_load(vst, T.v, d, tid);
    __builtin_amdgcn_sched_barrier(0);
    const float cb = exp2f(-(float)(d.h + 1)) * (float)d.dil * 1.4426950408889634f;
    const float NEG = -__builtin_inff();
    const float bl = cb * (float)(4 * hi - 128 - r32);
    const bool edge = Pq0 < 128;
    float mx = NEG;
#pragma unroll
    for (int t = 0; t < 5; ++t) {
        f32x4 rk4[4];
#pragma unroll
        for (int g4 = 0; g4 < 4; ++g4) rk4[g4] = *(const LAS f32x4*)(rkb + 32 * (wave + t) + 8 * g4 + 4 * hi);
        const float bt = bl + cb * (float)(32 * t);
#pragma unroll
        for (int r = 0; r < 16; ++r) { const int k0 = (r & 3) + 8 * (r >> 2);
            float s = __builtin_fmaf(p[t][r], rk4[r >> 2][r & 3], __builtin_fmaf(cb, (float)k0, bt));
            if (t == 0) s = (k0 + 4 * hi >= r32) ? s : NEG;
            if (t == 4) s = (k0 + 4 * hi <= r32) ? s : NEG;
            p[t][r] = s; }
        if (edge) {
#pragma unroll
            for (int r = 0; r < 16; ++r) { const int kk = (r & 3) + 8 * (r >> 2) + 4 * hi; if (Pq0 - 128 + 32 * t + kk < 0) p[t][r] = NEG; } }
#pragma unroll
        for (int r = 0; r < 16; r += 2) mx = __builtin_fmaxf(__builtin_fmaxf(mx, p[t][r]), p[t][r + 1]); }
    { auto rr = __builtin_amdgcn_permlane32_swap(__float_as_uint(mx), __float_as_uint(mx), false, false); mx = fmaxf(__uint_as_float(rr[0]), __uint_as_float(rr[1])); }
    float ls = 0.f;
    bf16x8 pa[5][2];
#define ATT_PK4(P, B_, OUT) do { unsigned a0 = cvtpk(P[B_ + 0], P[B_ + 1]), a1 = cvtpk(P[B_ + 2], P[B_ + 3]); unsigned b0 = cvtpk(P[B_ + 4], P[B_ + 5]), b1 = cvtpk(P[B_ + 6], P[B_ + 7]); \
        auto r0 = __builtin_amdgcn_permlane32_swap(a0, b0, false, false); auto r1 = __builtin_amdgcn_permlane32_swap(a1, b1, false, false); \
        u32x4 w = {r0[0], r1[0], r0[1], r1[1]}; OUT = __builtin_bit_cast(bf16x8, w); } while (0)
#pragma unroll
    for (int t = 0; t < 5; ++t) {
#pragma unroll
        for (int r = 0; r < 16; ++r) { const float e = __builtin_amdgcn_exp2f(p[t][r] - mx); p[t][r] = e; ls += e; }
        ATT_PK4(p[t], 0, pa[t][0]); ATT_PK4(p[t], 8, pa[t][1]); }
#undef ATT_PK4
    { auto rr = __builtin_amdgcn_permlane32_swap(__float_as_uint(ls), __float_as_uint(ls), false, false); ls = __uint_as_float(rr[0]) + __uint_as_float(rr[1]); }
    ATT_STAMP();
    __syncthreads();
    stage_write_v(vst, lds, tid);
    const int nxt = fetch_next.publish(nxt_raw);
    const bool nxt_valid = nxt < n_total;
    ATT_STAMP();
    __builtin_amdgcn_sched_barrier(0);
    f32x16 o[4] = {};
    { const LAS char* vrd = lds + wave * 8192 + v_rd_base(lane);
#pragma unroll
      for (int t = 0; t < 5; ++t) { const LAS char* vb = vrd + t * 8192;
#pragma unroll
          for (int d0 = 0; d0 < 4; ++d0) {
              const s16x4 l0 = vtr(vb + v_rd_off(d0, 0, 0)), h0 = vtr(vb + v_rd_off(d0, 0, 1)), l1 = vtr(vb + v_rd_off(d0, 1, 0)), h1 = vtr(vb + v_rd_off(d0, 1, 1));
              o[d0] = __builtin_amdgcn_mfma_f32_32x32x16_bf16(pa[t][0], (bf16x8){l0[0], l0[1], l0[2], l0[3], h0[0], h0[1], h0[2], h0[3]}, o[d0], 0, 0, 0);
              o[d0] = __builtin_amdgcn_mfma_f32_32x32x16_bf16(pa[t][1], (bf16x8){l1[0], l1[1], l1[2], l1[3], h1[0], h1[1], h1[2], h1[3]}, o[d0], 0, 0, 0); }
          __builtin_amdgcn_sched_barrier(0);
          if (t == 1 && nxt_valid) { const UnitId dn = decode((nxt - n_ssm) % 1536); stage_load<0, 4>(c.kst, T.k, dn, tid); __builtin_amdgcn_sched_barrier(0); }
          if (t == 3 && nxt_valid) { const UnitId dn = decode((nxt - n_ssm) % 1536); stage_load<4, 8>(c.kst, T.k, dn, tid); __builtin_amdgcn_sched_barrier(0); } } }
    ATT_STAMP();
    if (hi == 0) { lib[r32] = ls; *(f32x2*)(T.aml + ((size_t)d.br * M + rowbase + tq) * 16 + 2 * d.h) = (f32x2){mx, ls}; }
    bf16* ao = T.ao + (size_t)d.br * M * 1024;
    float rl[16];
#pragma unroll
    for (int r = 0; r < 16; ++r) rl[r] = 1.0f / lib[crow(r, hi)];
    LAS unsigned short* stg = (LAS unsigned short*)(lds + CO_OST + wave * 4608);
#pragma unroll
    for (int hh = 0; hh < 2; ++hh) {
#pragma unroll
        for (int r = 0; r < 16; ++r) { const int orow = crow(r, hi);
            const unsigned w2 = pk2(o[2 * hh][r] * rl[r], o[2 * hh + 1][r] * rl[r]);
            stg[orow * 72 + r32] = (unsigned short)w2; stg[orow * 72 + 32 + r32] = (unsigned short)(w2 >> 16); }
#pragma unroll
        for (int i = 0; i < 4; ++i) { const int row = 8 * i + (lane >> 3), ch = lane & 7;
            const u32x4 v = *(const LAS u32x4*)(stg + row * 72 + ch * 8);
            *(u32x4*)(ao + (rowbase + d.dil * (Pq0 + row) + d.res) * 1024 + d.h * 128 + hh * 64 + ch * 8) = v; } }
    __builtin_amdgcn_sched_barrier(0);
    if (nxt_valid) { const UnitId dn = decode((nxt - n_ssm) % 1536); carry_load_rest(c, T, dn, tid, wave, lane); __builtin_amdgcn_sched_barrier(0); }
    __syncthreads();
    ATT_STAMP();
#ifdef PROBE_ATT
    if (u == 777 && tid == 0) { for (int i = 0; i < 6; ++i) __hip_atomic_store(T.probe + i, (unsigned)(ts_[i + 1] - ts_[i]), __ATOMIC_RELAXED, __HIP_MEMORY_SCOPE_AGENT); }
#endif
    return nxt;
}
}

typedef float f32x2m __attribute__((ext_vector_type(2)));
__device__ __forceinline__ void p4_merge(Frame& F) {
    const bf16* ao = (const bf16*)(F.ws + WS_ATT); const float* aml = (const float*)(F.ws + WS_AML); bf16* mixed = (bf16*)(F.ws + WS_MIXED);
    constexpr int NT = M * 128, U = 4;
    const int stride = F.G * 512;
    for (int i0 = F.vcu * 512 + F.tid; i0 < NT; i0 += U * stride) {
        f32x2m ml[U][3]; v4u v[U][3];
#pragma unroll
        for (int q = 0; q < U; ++q) { const int i = i0 + q * stride < NT ? i0 + q * stride : i0; const int row = i >> 7, c8 = i & 127, h = c8 >> 4;
#pragma unroll
            for (int b3 = 0; b3 < 3; ++b3) { ml[q][b3] = *(const f32x2m*)(aml + ((size_t)b3 * M + row) * 16 + 2 * h); v[q][b3] = NT_LOADA((const v4u*)(ao + ((size_t)b3 * M + row) * 1024 + c8 * 8)); } }
#pragma unroll
        for (int q = 0; q < U; ++q) { const int i = i0 + q * stride; if (i >= NT) break; const int row = i >> 7, c8 = i & 127;
            const float mm = fmaxf(ml[q][0].x, fmaxf(ml[q][1].x, ml[q][2].x));
            float w[3], ws_ = 0.f;
#pragma unroll
            for (int b3 = 0; b3 < 3; ++b3) { w[b3] = __builtin_amdgcn_exp2f(ml[q][b3].x - mm) * ml[q][b3].y; ws_ += w[b3]; }
            const float rw = 1.0f / ws_;
            float acc[8] = {0.f, 0.f, 0.f, 0.f, 0.f, 0.f, 0.f, 0.f};
#pragma unroll
            for (int b3 = 0; b3 < 3; ++b3) { const v4u vv = v[q][b3]; const float wn = w[b3] * rw;
                acc[0] += wn * __uint_as_float(vv.x << 16); acc[1] += wn * __uint_as_float(vv.x & 0xffff0000u); acc[2] += wn * __uint_as_float(vv.y << 16); acc[3] += wn * __uint_as_float(vv.y & 0xffff0000u);
                acc[4] += wn * __uint_as_float(vv.z << 16); acc[5] += wn * __uint_as_float(vv.z & 0xffff0000u); acc[6] += wn * __uint_as_float(vv.w << 16); acc[7] += wn * __uint_as_float(vv.w & 0xffff0000u); }
            v4u o; o.x = pk2(acc[0], acc[1]); o.y = pk2(acc[2], acc[3]); o.z = pk2(acc[4], acc[5]); o.w = pk2(acc[6], acc[7]);
            *(v4u*)(mixed + (size_t)row * 2048 + 1024 + c8 * 8) = o; } }
}

namespace ssm {
typedef short bf16x8 __attribute__((ext_vector_type(8)));
typedef float f32x4 __attribute__((ext_vector_type(4)));
typedef unsigned u32x4 __attribute__((ext_vector_type(4)));
typedef unsigned u32x2 __attribute__((ext_vector_type(2)));
constexpr int LDS_KT = 1024, LDS_BIG = 17408;
constexpr int NCH = 256;
constexpr int W1P = 1040, CMP = 272;

struct Ptrs { const bf16* ug; bf16* yg; const bf16* W1; const bf16* CM; const bf16* KT; const float* A32; const float* D; float* Hs; bf16* CIs; unsigned* probe; };
#ifdef PROBE_SSM
#define SSM_STAMP() do { __builtin_amdgcn_sched_barrier(0); ts_[nst_++] = __builtin_amdgcn_s_memrealtime(); __builtin_amdgcn_sched_barrier(0); } while (0)
#else
#define SSM_STAMP() do {} while (0)
#endif

template <int HALF>
__device__ __forceinline__ void s3_half(const Ptrs& T, LAS unsigned char* lds, const bf16* up, bf16x8 (&ub)[16], const bf16x8 (&cbf)[4], const f32x4 dv, int b, int g, int ct, int ch, int kg, int ct_next) {
    constexpr int NKS = 8 * (HALF + 1);
    u32x2 uw[16];
#pragma unroll
    for (int tt = 0; tt < 16; ++tt) uw[tt] = *(const u32x2*)(up + (size_t)(32 * (16 * ct + ch) + 16 * HALF + tt) * 16 + 4 * kg);
    f32x4 acc[16];
#pragma unroll
    for (int t = 0; t < 16; ++t) acc[t] = (f32x4){0.f, 0.f, 0.f, 0.f};
    const LAS unsigned char* ktb = lds + LDS_KT + ch * 32 + (kg & 1) * 16 - (kg >> 1) * 512;
    constexpr int NDL = 16 * (HALF + 1);
    bf16x8 fa = *(const LAS bf16x8*)(ktb + (kg >> 1) * 512);
    if ((kg >> 1) != 0) fa = (bf16x8){0, 0, 0, 0, 0, 0, 0, 0};
#pragma unroll
    for (int dl = 0; dl < NDL; ++dl) {
        bf16x8 fn = fa;
        if (dl + 1 < NDL) fn = *(const LAS bf16x8*)(ktb + (dl + 1) * 512);
        __builtin_amdgcn_sched_barrier(0);
#pragma unroll
        for (int ks = 0; ks < NKS; ++ks) { const int t = 2 * ks + dl; if (t >= 16 * HALF && t < 16 * HALF + 16) acc[t - 16 * HALF] = __builtin_amdgcn_mfma_f32_16x16x32_bf16(fa, ub[ks], acc[t - 16 * HALF], 0, 0, 0); }
        __builtin_amdgcn_sched_barrier(0);
        fa = fn; }
    if (HALF == 1 && ct_next >= 0) {
#pragma unroll
        for (int ks = 0; ks < 16; ++ks) ub[ks] = *(const bf16x8*)(up + (size_t)(32 * (16 * ct_next + ch) + 2 * ks + (kg >> 1)) * 16 + 8 * (kg & 1));
        __builtin_amdgcn_sched_barrier(0); }
    const LAS unsigned char* cmb = lds + LDS_BIG + (HALF * 256 + ch) * CMP + kg * 16;
    bf16x8 ca[4];
#pragma unroll
    for (int ks = 0; ks < 4; ++ks) ca[ks] = *(const LAS bf16x8*)(cmb + ks * 64);
#pragma unroll
    for (int tt = 0; tt < 16; ++tt) {
        bf16x8 cn[4];
#pragma unroll
        for (int ks = 0; ks < 4; ++ks) cn[ks] = ca[ks];
        if (tt + 1 < 16) {
#pragma unroll
            for (int ks = 0; ks < 4; ++ks) cn[ks] = *(const LAS bf16x8*)(cmb + (tt + 1) * 16 * CMP + ks * 64); }
        __builtin_amdgcn_sched_barrier(0);
#pragma unroll
        for (int ks = 0; ks < 4; ++ks) acc[tt] = __builtin_amdgcn_mfma_f32_16x16x32_bf16(ca[ks], cbf[ks], acc[tt], 0, 0, 0);
        __builtin_amdgcn_sched_barrier(0);
#pragma unroll
        for (int ks = 0; ks < 4; ++ks) ca[ks] = cn[ks]; }
#pragma unroll
    for (int tt = 0; tt < 16; ++tt) { const int tok = 32 * (16 * ct + ch) + 16 * HALF + tt;
        const float y0 = acc[tt][0] + dv[0] * __uint_as_float(uw[tt].x << 16), y1 = acc[tt][1] + dv[1] * __uint_as_float(uw[tt].x & 0xffff0000u);
        const float y2 = acc[tt][2] + dv[2] * __uint_as_float(uw[tt].y << 16), y3 = acc[tt][3] + dv[3] * __uint_as_float(uw[tt].y & 0xffff0000u);
        u32x2 o; o.x = pk2(gelu_tanh(y0), gelu_tanh(y1)); o.y = pk2(gelu_tanh(y2), gelu_tanh(y3));
        *(u32x2*)(T.yg + (size_t)(b * SEQ + tok) * 1024 + g * 16 + 4 * kg) = o;
        if ((tt & 3) == 3) __builtin_amdgcn_sched_barrier(0); }
}
__device__ __forceinline__ void item(const Ptrs& T, int it, LAS unsigned char* lds, int tid, int wave, int lane) {
#ifdef PROBE_SSM
    unsigned long long ts_[8]; int nst_ = 0;
#endif
    SSM_STAMP();
    const int b = it >> 6, g = it & 63;
    const bf16* up = T.ug + (size_t)((b * 64 + g) * SEQ) * 16;
    float* Hs = T.Hs + (size_t)it * NCH * 128; bf16* CIs = T.CIs + (size_t)it * NCH * 128;
    const int ch = lane & 15, kg = lane >> 4;
    { const u32x4* src = (const u32x4*)(T.KT + (size_t)g * 32 * 256);
#pragma unroll
      for (int i = 0; i < 2; ++i) *(LAS u32x4*)(lds + LDS_KT + (tid + 512 * i) * 16) = src[tid + 512 * i];
      const u32x4* w1 = (const u32x4*)(T.W1 + (size_t)g * 128 * 512);
#pragma unroll
      for (int i = 0; i < 16; ++i) { const int c = tid + 512 * i, r = c >> 6, ci = c & 63; *(LAS u32x4*)(lds + LDS_BIG + r * W1P + ci * 16) = w1[c]; } }
    __syncthreads();
    SSM_STAMP();
    const LAS unsigned char* w1b = lds + LDS_BIG + ch * W1P + kg * 16;
#pragma unroll 1
    for (int cti = 0; cti < 2; ++cti) { const int ct = wave + 8 * cti;
        bf16x8 ub[16];
#pragma unroll
        for (int ks = 0; ks < 16; ++ks) ub[ks] = *(const bf16x8*)(up + (size_t)(32 * (16 * ct + ch) + 2 * ks + (kg >> 1)) * 16 + 8 * (kg & 1));
#pragma unroll
        for (int n2t = 0; n2t < 8; ++n2t) { f32x4 hacc = {0.f, 0.f, 0.f, 0.f};
#pragma unroll
            for (int ks = 0; ks < 16; ++ks) { const bf16x8 a = *(const LAS bf16x8*)(w1b + n2t * 16 * W1P + ks * 64);
                hacc = __builtin_amdgcn_mfma_f32_16x16x32_bf16(a, ub[ks], hacc, 0, 0, 0); }
            *(f32x4*)(Hs + (size_t)(16 * ct + ch) * 128 + n2t * 16 + 4 * kg) = hacc; __builtin_amdgcn_sched_barrier(0); } }
    asm volatile("s_waitcnt vmcnt(0)" ::: "memory");
    __syncthreads();
    SSM_STAMP();
    { const int n = tid & 63, seg = tid >> 6;
      float yr[32], yi[32];
#pragma unroll
      for (int j = 0; j < 32; ++j) { yr[j] = NT_LOADA(Hs + (size_t)(32 * seg + j) * 128 + n); yi[j] = NT_LOADA(Hs + (size_t)(32 * seg + j) * 128 + 64 + n); }
      const float ar = T.A32[(g * 64 + n) * 2], ai = T.A32[(g * 64 + n) * 2 + 1];
#pragma unroll
      for (int j = 1; j < 32; ++j) { const float pr = yr[j - 1], pi = yi[j - 1]; yr[j] += ar * pr - ai * pi; yi[j] += ar * pi + ai * pr; }
      float qr_ = ar, qi_ = ai;
#pragma unroll
      for (int k = 0; k < 5; ++k) { const float tr = qr_ * qr_ - qi_ * qi_, ti = 2.0f * qr_ * qi_; qr_ = tr; qi_ = ti; }
      LAS float* segt = (LAS float*)(lds + LDS_BIG);
      segt[(seg * 64 + n) * 2] = yr[31]; segt[(seg * 64 + n) * 2 + 1] = yi[31];
      __syncthreads();
      float sr = 0.f, si = 0.f;
      for (int k = 0; k < seg; ++k) { const float er = segt[(k * 64 + n) * 2], ei = segt[(k * 64 + n) * 2 + 1]; const float tr = qr_ * sr - qi_ * si + er, ti = qr_ * si + qi_ * sr + ei; sr = tr; si = ti; }
      float pr = sr, pi = si;
#pragma unroll
      for (int j = 0; j < 32; ++j) { const float cr = (j == 0 ? 0.f : yr[j > 0 ? j - 1 : 0]) + pr, ci = (j == 0 ? 0.f : yi[j > 0 ? j - 1 : 0]) + pi;
          CIs[(size_t)(32 * seg + j) * 128 + n] = (bf16)f2bf(cr); CIs[(size_t)(32 * seg + j) * 128 + 64 + n] = (bf16)f2bf(ci);
          const float tr = ar * pr - ai * pi, ti = ar * pi + ai * pr; pr = tr; pi = ti; } }
    asm volatile("s_waitcnt vmcnt(0)" ::: "memory");
    __syncthreads();
    SSM_STAMP();
    { const u32x4* cm = (const u32x4*)(T.CM + (size_t)g * 512 * 128);
#pragma unroll
      for (int i = 0; i < 16; ++i) { const int c = tid + 512 * i, r = c >> 4, ci = c & 15; *(LAS u32x4*)(lds + LDS_BIG + r * CMP + ci * 16) = cm[c]; } }
    __syncthreads();
    SSM_STAMP();
    const f32x4 dv = *(const f32x4*)(T.D + g * 16 + 4 * kg);
    bf16x8 ubs[16];
#pragma unroll
    for (int ks = 0; ks < 16; ++ks) ubs[ks] = *(const bf16x8*)(up + (size_t)(32 * (16 * wave + ch) + 2 * ks + (kg >> 1)) * 16 + 8 * (kg & 1));
#pragma unroll 1
    for (int cti = 0; cti < 2; ++cti) { const int ct = wave + 8 * cti;
        bf16x8 cbf[4];
#pragma unroll
        for (int ks = 0; ks < 4; ++ks) cbf[ks] = *(const bf16x8*)(CIs + (size_t)(16 * ct + ch) * 128 + 32 * ks + 8 * kg);
        s3_half<0>(T, lds, up, ubs, cbf, dv, b, g, ct, ch, kg, -1);
        s3_half<1>(T, lds, up, ubs, cbf, dv, b, g, ct, ch, kg, cti == 0 ? wave + 8 : -1); }
    __syncthreads();
    SSM_STAMP();
#ifdef PROBE_SSM
    if (it == 5 && tid == 0) { for (int i = 0; i < 5; ++i) __hip_atomic_store(T.probe + i, (unsigned)(ts_[i + 1] - ts_[i]), __ATOMIC_RELAXED, __HIP_MEMORY_SCOPE_AGENT); }
#endif
}
}

__device__ __forceinline__ void cpow_fast(float pw, float lr, float th, float& xr, float& xi) {
    const float mg = __builtin_amdgcn_exp2f(pw * lr * 1.4426950408889634f);
    const float rev = __builtin_amdgcn_fractf(pw * th * 0.15915494309189535f);
    xr = mg * __builtin_amdgcn_cosf(rev); xi = mg * __builtin_amdgcn_sinf(rev);
}
__device__ __forceinline__ void p0_ssm_consts(Frame& F) {
    bf16* W1 = (bf16*)(F.ws + WS_SC_W1); bf16* CM = (bf16*)(F.ws + WS_SC_CM); bf16* KT = (bf16*)(F.ws + WS_SC_KT); float* A32 = (float*)(F.ws + WS_SC_A32);
    LAS float* bbr = (LAS float*)(F.lds); LAS float* bbi = bbr + 1024; LAS float* cre = bbi + 1024; LAS float* cim = cre + 1024;
    LAS float* lr = cim + 1024; LAS float* th = lr + 64; LAS float* er = th + 64; LAS float* ei = er + 128;
    LAS float* bbrT = ei + 128; LAS float* bbiT = bbrT + 16 * 68;
    for (int it = blockIdx.x; it < 256; it += F.G) { const int g = it >> 2, part = it & 3;
        const float dt = expf(F.in[8][g]);
#pragma unroll
        for (int i = 0; i < 2; ++i) { const int e = F.tid + 512 * i, n = e >> 4;
            const float are = F.in[6][g * 64 + n], aim = F.in[7][g * 64 + n];
            const float mag = expf(are * dt), abr = mag * cosf(aim * dt), abi = mag * sinf(aim * dt);
            const float nre = abr - 1.0f, nim = abi, den = are * are + aim * aim;
            const float zre = (nre * are + nim * aim) / den, zim = (nim * are - nre * aim) / den;
            const float br = F.in[9][g * 1024 + e], bi = F.in[10][g * 1024 + e];
            bbr[e] = zre * br - zim * bi; bbi[e] = zre * bi + zim * br;
            bbrT[(e & 15) * 68 + n] = zre * br - zim * bi; bbiT[(e & 15) * 68 + n] = zre * bi + zim * br;
            cre[e] = F.in[11][g * 1024 + e]; cim[e] = F.in[12][g * 1024 + e];
            if ((e & 15) == 0) { lr[n] = are * dt; th[n] = aim * dt; } }
        __syncthreads();
        { const int n = F.tid & 63, j = F.tid >> 6;
          {
              const int s = 8 * part + j; float xr, xi; cpow_fast((float)(31 - s), lr[n], th[n], xr, xi);
              unsigned wr_[8], wi_[8];
#pragma unroll
              for (int c2 = 0; c2 < 8; ++c2) { const float b0r = bbr[n * 16 + 2 * c2], b0i = bbi[n * 16 + 2 * c2], b1r = bbr[n * 16 + 2 * c2 + 1], b1i = bbi[n * 16 + 2 * c2 + 1];
                  wr_[c2] = pk2(xr * b0r - xi * b0i, xr * b1r - xi * b1i); wi_[c2] = pk2(xr * b0i + xi * b0r, xr * b1i + xi * b1r); }
              v4u* dr = (v4u*)(W1 + ((size_t)g * 128 + n) * 512 + s * 16); v4u* di = (v4u*)(W1 + ((size_t)g * 128 + 64 + n) * 512 + s * 16);
              dr[0] = (v4u){wr_[0], wr_[1], wr_[2], wr_[3]}; dr[1] = (v4u){wr_[4], wr_[5], wr_[6], wr_[7]};
              di[0] = (v4u){wi_[0], wi_[1], wi_[2], wi_[3]}; di[1] = (v4u){wi_[4], wi_[5], wi_[6], wi_[7]}; }
          {
              const int t = 8 * part + j; float xr, xi; cpow_fast((float)(t + 1), lr[n], th[n], xr, xi);
#pragma unroll
              for (int co = 0; co < 16; ++co) { const float c_r = cre[co * 64 + n], c_i = cim[co * 64 + n];
                  CM[((size_t)g * 512 + t * 16 + co) * 128 + n] = (bf16)f2bf(c_r * xr - c_i * xi); CM[((size_t)g * 512 + t * 16 + co) * 128 + 64 + n] = (bf16)f2bf(-(c_r * xi + c_i * xr)); } }
          if (part == 0 && j == 0) { const float mg = expf(32.0f * lr[n]); float sn, cs; sincosf(32.0f * th[n], &sn, &cs); A32[(g * 64 + n) * 2] = mg * cs; A32[(g * 64 + n) * 2 + 1] = mg * sn; } }
        for (int rr = 0; rr < 4; ++rr) {
            __syncthreads();
            if (F.tid < 128) { const int n = F.tid & 63, ts = F.tid >> 6; float xr, xi; cpow_fast((float)(8 * part + 2 * rr + ts), lr[n], th[n], xr, xi); er[ts * 64 + n] = xr; ei[ts * 64 + n] = xi; }
            __syncthreads();
            const int ts = F.tid >> 8, co = (F.tid >> 4) & 15, ci = F.tid & 15; float a = 0.f;
#pragma unroll 4
            for (int n = 0; n < 64; n += 4) { const f32x4 c_r = *(const LAS f32x4*)(cre + co * 64 + n), c_i = *(const LAS f32x4*)(cim + co * 64 + n), e_r = *(const LAS f32x4*)(er + ts * 64 + n), e_i = *(const LAS f32x4*)(ei + ts * 64 + n);
                const f32x4 b_r = *(const LAS f32x4*)(bbrT + ci * 68 + n), b_i = *(const LAS f32x4*)(bbiT + ci * 68 + n);
                const f32x4 v = (c_r * e_r - c_i * e_i) * b_r - (c_r * e_i + c_i * e_r) * b_i; a += (v[0] + v[1]) + (v[2] + v[3]); }
            KT[((size_t)g * 32 + 8 * part + 2 * rr + ts) * 256 + co * 16 + ci] = (bf16)f2bf(a); }
        __syncthreads();
    }
}
#ifndef SSM_NAIVE
#define SSM_NAIVE 0
#endif
#ifndef ATTN_NAIVE
#define ATTN_NAIVE 0
#endif
struct QFetch { unsigned* q; volatile LAS unsigned* misc; int tid;
    __device__ __forceinline__ int operator()() const { if (tid == 0) misc[0] = atomicAdd(q, 1u); __syncthreads(); return (int)misc[0]; }
    __device__ __forceinline__ unsigned issue() const { unsigned v = 0u; if (tid == 0) v = atomicAdd(q, 1u); return v; }
    __device__ __forceinline__ int publish(unsigned v) const { if (tid == 0) misc[0] = v; __syncthreads(); return (int)misc[0]; } };
__device__ __forceinline__ void stagger(int group, unsigned step_ticks) { const unsigned long long t0 = __builtin_amdgcn_s_memrealtime(); const unsigned long long w = (unsigned long long)group * step_ticks;
    while (__builtin_amdgcn_s_memrealtime() - t0 < w) __builtin_amdgcn_s_sleep(8); }
#ifndef STG5
#define STG5 1000
#endif
#ifndef STG7
#define STG7 600
#endif
#ifndef WGM_P2
#define WGM_P2 4
#endif
#ifndef WGM_P4
#define WGM_P4 4
#endif
#ifndef WGM_P5
#define WGM_P5 4
#endif
#ifndef WGM_P6
#define WGM_P6 8
#endif
#ifndef WGM_P7
#define WGM_P7 4
#endif
struct Args { const float* in[22]; float* out; unsigned char* ws; int ph_lo, ph_hi; };
__global__ void __launch_bounds__(NWAVES * 64, 2) mk_fwd(Args args) {
    extern __shared__ __attribute__((aligned(16))) unsigned char lds[];
    Frame F;
    F.lds = (LAS unsigned char*)lds;
    F.MISC = (volatile LAS unsigned*)(F.lds + MISC_OFF);
    F.tid = threadIdx.x; F.lane = F.tid & 63; F.wave = __builtin_amdgcn_readfirstlane(F.tid >> 6);
    F.G = gridDim.x; { const int bx = blockIdx.x; F.vcu = (F.G % 8 == 0) ? (bx % 8) * (F.G / 8) + bx / 8 : bx; }
    unsigned char* ws = args.ws; F.ws = ws; F.out = args.out;
    F.ctl = (gu32*)(ws + WS_CTL);
#pragma unroll
    for (int i = 0; i < 22; ++i) F.in[i] = args.in[i];
    const int lo = args.ph_lo, hi = args.ph_hi;
    const bool use_bar = (hi - lo) > 1;
    for (int u = F.tid; u < (LDS_BYTES - LDSCTL_OFF) / 4; u += NWAVES * 64) ((LAS unsigned*)(F.lds + LDSCTL_OFF))[u] = 0u;
    __syncthreads();
    XcdBarrier bar; bar.bar = (unsigned*)(F.ctl + CW_BAR); bar.x = 0; bar.st = nullptr;
    if (use_bar) bar = xcd_barrier_post((unsigned*)(F.ctl + CW_BAR), F.MISC + 8);
#define IN(k) (lo <= (k) && (k) < hi)
#ifdef PROBE_PHASE
    unsigned long long t_p0 = 0, t_p1 = 0;
#define PT0(k) do { if ((k) == PROBE_PHASE && blockIdx.x == 0 && F.tid == 0) t_p0 = rt(); } while (0)
#define PT1(k) do { if ((k) == PROBE_PHASE && blockIdx.x == 0 && F.tid == 0) t_p1 = rt(); } while (0)
#else
#define PT0(k) do {} while (0)
#define PT1(k) do {} while (0)
#endif
#define SEAM(k) do { if (IN(k) && IN((k) + 1)) xcd_barrier(bar); } while (0)
    bf16* const W_in_t = (bf16*)(ws + WS_WIN); bf16* const W_glu_t = (bf16*)(ws + WS_WGLU); bf16* const W_out_t = (bf16*)(ws + WS_WOUT);
    bf16* const W_gu_t = (bf16*)(ws + WS_WGU); bf16* const W_d_t = (bf16*)(ws + WS_WD);
    float* const mod = (float*)(ws + WS_MOD); float* const ssqk = (float*)(ws + WS_SSQK); float* const ss2 = (float*)(ws + WS_SS2); float* const cb = (float*)(ws + WS_CB);

#ifndef P0_STAGGER
#define P0_STAGGER 1
#endif
    if (IN(0)) { PT0(0);
        if (P0_STAGGER && (((int)blockIdx.x >> 3) & 1)) { p0_ssm_consts(F); __syncthreads(); p0_prologue(F); __syncthreads(); }
        else { p0_prologue(F); __syncthreads(); p0_ssm_consts(F); __syncthreads(); }
        p0_rest(F);
        if (IN(1)) wait_mod_done(F);
        PT1(0); }
    if (IN(1)) { PT0(1); p1_norm1(F);
#if defined(REP_PHASE) && REP_PHASE == 1
        p1_norm1(F);
#endif
        SEAM(1); PT1(1); }
    if (IN(2)) { PT0(2);
        pg8::Gemm g{(const bf16*)(ws + WS_H1), W_in_t, M, NPROJ, DM}; pg8::StaticOrder S; S.init(M, NPROJ, F.G, (int)blockIdx.x, WGM_P2);
        pg8::EpiProj E{(bf16*)(ws + WS_UG), (bf16*)(ws + WS_Q), (size_t)(WS_K - WS_Q) / 2, ssqk};
        pg8::gemm_phase<pg8::EpiProj, pg8::StaticOrder, true, true>(F.lds + RING_OFF, g, S, E);
        SEAM(2); PT1(2);
    }
    if (IN(3)) { PT0(3);
        if (F.tid < 128) ((LAS float*)(F.lds + att::WQK_OFF))[F.tid] = F.in[15][F.tid] * F.in[16][F.tid];
        __syncthreads();
        const att::Ptrs AT{(const bf16*)(ws + WS_Q), (const bf16*)(ws + WS_K), (const bf16*)(ws + WS_V), ssqk, (bf16*)(ws + WS_ATT), (float*)(ws + WS_AML), (unsigned*)(F.ctl + 200)};
        const ssm::Ptrs ST{(const bf16*)(ws + WS_UG), (bf16*)(ws + WS_YG), (const bf16*)(ws + WS_SC_W1), (const bf16*)(ws + WS_SC_CM), (const bf16*)(ws + WS_SC_KT), (const float*)(ws + WS_SC_A32), F.in[13], (float*)(ws + WS_MIXED), (bf16*)(ws + WS_MIXED + 32 * MiB), (unsigned*)(F.ctl + 220)};
#if defined(PROBE_2X_SSM)
        constexpr int n_ssm = 256, n_att = 1536;
#elif defined(PROBE_2X_ATT)
        constexpr int n_ssm = 128, n_att = 3072;
#else
        constexpr int n_ssm = SSM_NAIVE ? 0 : 128, n_att = ATTN_NAIVE ? 0 : 1536;
#endif
#ifdef PROBE_SSM_END
        const unsigned long long t_wg0 = rt();
#endif
        if (LATE_TR && (F.vcu & 1)) {
            const int hw = (F.vcu >> 1) * NWAVES + F.wave, HW = (F.G >> 1) * NWAVES;
            for (int it = hw; it < TR_TOTAL; it += HW) { int lane_l = F.lane; asm volatile("" : "+v"(lane_l)); tr_wave_item(F, it, lane_l); }
            __syncthreads();
        }
        const QFetch fetch{(unsigned*)(F.ctl + CW_Q), F.MISC, F.tid};
        constexpr int n_tr = 0;
#ifndef SSM_STATIC
#define SSM_STATIC 1
#endif
        const bool ssm_static = SSM_STATIC && LATE_TR && F.G == 256 && n_ssm == 128;
        int idx;
        if (ssm_static) {
            if (!(F.vcu & 1)) { int tid_l = F.tid; asm volatile("" : "+v"(tid_l)); ssm::item(ST, F.vcu >> 1, F.lds, tid_l, F.wave, tid_l & 63); }
            idx = fetch();
        } else {
            idx = fetch();
            while (n_ssm > 0 && idx < n_ssm) {
                int tid_l = F.tid; asm volatile("" : "+v"(tid_l));
                ssm::item(ST, idx & 127, F.lds, tid_l, F.wave, tid_l & 63);
                idx = fetch();
            }
        }
        const int qbase = ssm_static ? 0 : n_ssm + n_tr, qtotal = qbase + n_att;
        if (n_att > 0 && idx < qtotal) {
            att::Carry cy;
            { int tid_l = F.tid; asm volatile("" : "+v"(tid_l)); const att::UnitId d0 = att::decode((idx - qbase) % 1536);
              att::stage_load<0, 8>(cy.kst, AT.k, d0, tid_l); att::carry_load_rest(cy, AT, d0, tid_l, F.wave, tid_l & 63); }
            while (idx < qtotal) {
                int tid_l = F.tid; asm volatile("" : "+v"(tid_l));
                idx = att::unit_co(AT, (idx - qbase) % 1536, cy, (LAS char*)F.lds, tid_l, F.wave, tid_l & 63, qbase, qtotal, fetch);
            }
        }
        if (SSM_NAIVE) p3_ssm_naive(F);
        if (ATTN_NAIVE) p3_attn_naive(F);
        SEAM(3); PT1(3);
    }
    if (IN(4)) { PT0(4);
        if (!ATTN_NAIVE) p4_merge(F);
#if defined(REP_PHASE) && REP_PHASE == 4
        p4_merge(F);
#endif
        pg8::Gemm g{(const bf16*)(ws + WS_YG), W_glu_t, M, 1024, 1024}; pg8::StaticOrder S; S.init(M, 1024, F.G, (int)blockIdx.x, WGM_P4);
        pg8::EpiGlu E{(const bf16*)(ws + WS_YG), (bf16*)(ws + WS_MIXED)};
        pg8::gemm_phase<pg8::EpiGlu, pg8::StaticOrder, true, true>(F.lds + RING_OFF, g, S, E);
        SEAM(4); PT1(4);
    }
    if (IN(5)) { PT0(5);
        pg8::Gemm g{(const bf16*)(ws + WS_MIXED), W_out_t, M, DM, DM}; pg8::StaticOrder S; S.init(M, DM, F.G, (int)blockIdx.x, WGM_P5);
        pg8::EpiOut E{F.in[0], (bf16*)(ws + WS_A2), mod, ss2};
#ifdef PF_X5
        {
            float dsum = 0.f; pg8::Unit uu;
            for (int i = 0; S.next(i, uu); ++i) {
#pragma unroll
                for (int j = 0; j < 4; ++j) { const int ln = F.tid + 512 * j, r = ln >> 3, c = (ln & 7) * 32; dsum += *(const volatile float*)(F.in[0] + (size_t)(uu.pm * 256 + r) * DM + uu.pn * 256 + c); } }
            if (dsum == 1.2345e-30f) F.out[0] = dsum;
        }
#endif
        pg8::gemm_phase<pg8::EpiOut, pg8::StaticOrder, true, true>(F.lds + RING_OFF, g, S, E);
        SEAM(5); PT1(5);
    }
    if (IN(6)) { PT0(6);
        pg8::Gemm g{(const bf16*)(ws + WS_A2), W_gu_t, M, NGU, DM, (size_t)(WS_WGU1 - WS_WGU)}; pg8::StaticOrder S; S.init(M, NGU, F.G, (int)blockIdx.x, WGM_P6);
        pg8::EpiFfnUp E{(bf16*)(ws + WS_T), cb, ss2};
        pg8::gemm_phase<pg8::EpiFfnUp, pg8::StaticOrder, true, true>(F.lds + RING_OFF, g, S, E);
        SEAM(6); PT1(6);
    }
    if (IN(7)) { PT0(7);
        pg8::Gemm g{(const bf16*)(ws + WS_T), W_d_t, M, DM, FFN}; pg8::StaticOrder S; S.init(M, DM, F.G, (int)blockIdx.x, WGM_P7);
        pg8::EpiDown E{mod, (const bf16*)(ws + WS_A2), F.out};
        pg8::gemm_phase<pg8::EpiDown, pg8::StaticOrder, true, true>(F.lds + RING_OFF, g, S, E);
#ifdef PROBE_PHASE
        xcd_barrier(bar); PT1(7);
#ifdef PROBE_SSM_END
        if (blockIdx.x == 0 && F.tid == 0) t_p1 = t_p0 + __hip_atomic_load((unsigned*)(F.ctl + 128), __ATOMIC_RELAXED, __HIP_MEMORY_SCOPE_AGENT);
#endif
#ifdef PROBE_SSM
        if (blockIdx.x == 0 && F.tid == 0) { t_p0 = 0; t_p1 = 10ull * __hip_atomic_load((unsigned*)(F.ctl + 220 + PROBE_SSM), __ATOMIC_RELAXED, __HIP_MEMORY_SCOPE_AGENT); }
#endif
#ifdef PROBE_ATT
        if (blockIdx.x == 0 && F.tid == 0) { t_p0 = 0; t_p1 = 50ull * __hip_atomic_load((unsigned*)(F.ctl + 200 + PROBE_ATT), __ATOMIC_RELAXED, __HIP_MEMORY_SCOPE_AGENT); }
#endif
#ifdef PROBE_SSM_ITEM
        if (blockIdx.x == 0 && F.tid == 0) { t_p0 = 0; t_p1 = __hip_atomic_load((unsigned*)(F.ctl + 200), __ATOMIC_RELAXED, __HIP_MEMORY_SCOPE_AGENT); }
#endif
        if (blockIdx.x == 0 && F.tid == 0) F.out[0] += (float)(t_p1 - t_p0) * 0.001f;
#endif
    }
#undef IN
#undef SEAM
}

extern "C" void kernel_launch(void* const* d_in, const int* in_sizes, int n_in, void* d_out, int out_size, void* d_ws, size_t ws_size, hipStream_t stream) {
    static int grid = 0;
    if (grid == 0) {
        if (n_in != 22 || in_sizes[0] != M * DM || out_size != M * DM || ws_size < WS_END) { fprintf(stderr, "kernel_launch: unexpected shapes (n_in %d, in0 %d, out %d, ws %zu)\n", n_in, n_in > 0 ? in_sizes[0] : -1, out_size, ws_size); grid = -1; return; }
        int dev = 0, cus = 0;
        if (hipGetDevice(&dev) != hipSuccess || hipDeviceGetAttribute(&cus, hipDeviceAttributeMultiprocessorCount, dev) != hipSuccess) { grid = -1; return; }
        if (hipFuncSetAttribute((const void*)mk_fwd, hipFuncAttributeMaxDynamicSharedMemorySize, LDS_BYTES) != hipSuccess) { fprintf(stderr, "kernel_launch: hipFuncSetAttribute failed\n"); grid = -1; return; }
        int per_cu = 0;
        if (hipOccupancyMaxActiveBlocksPerMultiprocessor(&per_cu, (const void*)mk_fwd, NWAVES * 64, LDS_BYTES) != hipSuccess || per_cu < 1) fprintf(stderr, "kernel_launch: occupancy query reports %d\n", per_cu);
        (void)hipGetLastError();
        grid = cus;
    }
    if (grid < 0) return;
    if (hipMemsetAsync((char*)d_ws + WS_CTL, 0, CTL_ZERO_BYTES, stream) != hipSuccess) return;
    Args a{};
    for (int i = 0; i < 22; ++i) a.in[i] = (const float*)d_in[i];
    a.out = (float*)d_out; a.ws = (unsigned char*)d_ws;
    if (MK_N_LAUNCHES == 1) { a.ph_lo = 0; a.ph_hi = N_PHASES; hipLaunchKernelGGL(mk_fwd, dim3(grid), dim3(NWAVES * 64), LDS_BYTES, stream, a); }
    else for (int p = 0; p < N_PHASES; ++p) { a.ph_lo = p; a.ph_hi = p + 1; hipLaunchKernelGGL(mk_fwd, dim3(grid), dim3(NWAVES * 64), LDS_BYTES, stream, a); }
}
```
